# Optimizing an MI355X kernel written in HIP

```python
import jax
import jax.numpy as jnp
from jax import lax
import numpy as np

D_MODEL = 1024
BATCH = 2
SEQ = 16384
DEPTH = 2

N_HEADS_MLA = 8
QK_NOPE_DIM = 64
QK_ROPE_DIM = 32
V_HEAD_DIM = 64
Q_LORA_RANK = 384
KV_LORA_RANK = 256
D_MLA = N_HEADS_MLA * V_HEAD_DIM

N_CONV_GROUPS = 4
CONV_GROUP_DIM = 64
D_CONV = N_CONV_GROUPS * CONV_GROUP_DIM
CONV_WIDTH = 3

N_FOURIER_GROUPS = 4
FOURIER_GROUP_DIM = 64
D_FOURIER = N_FOURIER_GROUPS * FOURIER_GROUP_DIM

D_MIX = D_MLA + D_CONV + D_FOURIER
IN_SPLITS = (Q_LORA_RANK, KV_LORA_RANK, QK_ROPE_DIM, D_CONV, D_CONV, D_CONV, D_FOURIER)
D_IN = sum(IN_SPLITS)

N_EXPERT_GROUPS = 4
EXPERTS_PER_GROUP = 8
TOP_K_IN_GROUP = 2
D_EXPERT = 256

Q_BLOCK = 128
ROPE_THETA = 10000.0
LN_EPS = 1e-5
RMS_EPS = 1e-6
DEEPNORM_ALPHA = (2.0 * DEPTH) ** 0.25
DEEPNORM_BETA = (8.0 * DEPTH) ** -0.25

kernel_name = 'hybrid_mla_conv_fourier_hmoe_deepnorm_encoder'


def layer_norm(x, g, b):
    xf = x.astype(jnp.float32)
    mu = jnp.mean(xf, -1, keepdims=True)
    xc = xf - mu
    var = jnp.mean(xc * xc, -1, keepdims=True)
    return (xc * lax.rsqrt(var + LN_EPS) * g.astype(jnp.float32) + b.astype(jnp.float32)).astype(x.dtype)


def rms_norm(x, g):
    xf = x.astype(jnp.float32)
    return (xf * lax.rsqrt(jnp.mean(xf * xf, -1, keepdims=True) + RMS_EPS) * g.astype(jnp.float32)).astype(x.dtype)


def rope_tables(seq_len, dtype):
    inv_freq = 1.0 / (ROPE_THETA ** (jnp.arange(0, QK_ROPE_DIM, 2, dtype=jnp.float32) / QK_ROPE_DIM))
    ang = jnp.arange(seq_len, dtype=jnp.float32)[:, None] * inv_freq[None, :]
    return jnp.cos(ang).astype(dtype), jnp.sin(ang).astype(dtype)


def apply_rope(t, cos, sin):
    t1, t2 = jnp.split(t, 2, axis=-1)
    return jnp.concatenate([t1 * cos - t2 * sin, t1 * sin + t2 * cos], axis=-1)


def mla_attention(c_q, c_kv, k_pe, g_q, g_kv, w_uq, w_ukv, cos, sin):
    bsz, seq, _ = c_q.shape
    q = jnp.einsum('bsr,rhd->bshd', rms_norm(c_q, g_q), w_uq)
    kv = jnp.einsum('bsr,rhd->bshd', rms_norm(c_kv, g_kv), w_ukv)
    q_nope = q[..., :QK_NOPE_DIM]
    q_pe = apply_rope(q[..., QK_NOPE_DIM:], cos[None, :, None, :], sin[None, :, None, :])
    k_nope = kv[..., :QK_NOPE_DIM]
    v = kv[..., QK_NOPE_DIM:]
    k_pe = apply_rope(k_pe, cos[None], sin[None])
    scale = (QK_NOPE_DIM + QK_ROPE_DIM) ** -0.5
    n_blk = seq // Q_BLOCK

    def to_blocks(t):
        return (t * scale).reshape(bsz, n_blk, Q_BLOCK, N_HEADS_MLA, t.shape[-1]).swapaxes(0, 1)

    def attend(blk):
        qn, qp = blk
        s = jnp.einsum('bqhd,bkhd->bhqk', qn, k_nope) + jnp.einsum('bqhr,bkr->bhqk', qp, k_pe)
        p = jax.nn.softmax(s.astype(jnp.float32), axis=-1).astype(v.dtype)
        return jnp.einsum('bhqk,bkhd->bqhd', p, v)

    o = lax.map(attend, (to_blocks(q_nope), to_blocks(q_pe)))
    return o.swapaxes(0, 1).reshape(bsz, seq, D_MLA)


def short_conv_mixer(b_gate, c_gate, h, w_conv):
    seq = h.shape[1]
    pad = CONV_WIDTH // 2
    up = jnp.pad(c_gate * h, ((0, 0), (pad, pad), (0, 0)))
    y = sum(up[:, k:k + seq] * w_conv[k] for k in range(CONV_WIDTH))
    return b_gate * y


def fourier_mixer(f):
    bsz, seq, _ = f.shape
    fg = f.astype(jnp.float32).reshape(bsz, seq, N_FOURIER_GROUPS, FOURIER_GROUP_DIM).transpose(0, 2, 1, 3)
    y = jnp.fft.fft2(fg, norm='ortho').real
    return y.transpose(0, 2, 1, 3).reshape(bsz, seq, D_FOURIER).astype(f.dtype)


def token_mixer(h, w_in, g_q, g_kv, w_uq, w_ukv, w_conv, w_out, cos, sin):
    z = jnp.einsum('bsd,dp->bsp', h, w_in)
    split_points = np.cumsum(IN_SPLITS)[:-1].tolist()
    c_q, c_kv, k_pe, b_gate, c_gate, hc, f = jnp.split(z, split_points, axis=-1)
    o_mla = mla_attention(c_q, c_kv, k_pe, g_q, g_kv, w_uq, w_ukv, cos, sin)
    o_conv = short_conv_mixer(b_gate, c_gate, hc, w_conv)
    o_four = fourier_mixer(f)
    o = jnp.concatenate([o_mla, o_conv, o_four], axis=-1)
    return jnp.einsum('bsm,md->bsd', o, w_out)


def hier_moe(h, w_group, b_group, w_router, b_router, w_gate, w_up, w_down):
    bsz, seq, d = h.shape
    xt = h.reshape(-1, d)
    g_prob = jax.nn.softmax((xt @ w_group + b_group).astype(jnp.float32), axis=-1)
    g_onehot = jax.nn.one_hot(jnp.argmax(g_prob, axis=-1), N_EXPERT_GROUPS, dtype=jnp.float32)
    p_group = jnp.sum(g_prob * g_onehot, -1, keepdims=True)
    e_logits_all = (jnp.einsum('nd,dge->nge', xt, w_router) + b_router).astype(jnp.float32)
    e_logits = jnp.einsum('nge,ng->ne', e_logits_all, g_onehot)
    e_prob = jax.nn.softmax(e_logits, axis=-1)
    top_p, top_i = lax.top_k(e_prob, TOP_K_IN_GROUP)
    top_p = top_p / jnp.sum(top_p, -1, keepdims=True)
    w_in_group = jnp.sum(jax.nn.one_hot(top_i, EXPERTS_PER_GROUP, dtype=jnp.float32) * top_p[..., None], axis=1) * p_group
    combine = (g_onehot[:, :, None] * w_in_group[:, None, :]).astype(h.dtype)
    out = jnp.zeros_like(xt)
    for g in range(N_EXPERT_GROUPS):
        a = jnp.einsum('nd,edf->nef', xt, w_gate[g])
        u = jnp.einsum('nd,edf->nef', xt, w_up[g])
        hid = jax.nn.silu(a) * u * combine[:, g, :, None]
        out = out + jnp.einsum('nef,efd->nd', hid, w_down[g])
    return out.reshape(bsz, seq, d)


def setup_inputs(seed: int = 0) -> dict:
    key = jax.random.key(seed)
    ks = jax.random.split(key, 24)
    f32 = jnp.float32
    L = DEPTH

    def nrm(k, shape, scale):
        return jax.random.normal(k, shape, f32) * scale

    return {
        'x': nrm(ks[0], (BATCH, SEQ, D_MODEL), 1.0),
        'ln_in_g': 1.0 + nrm(ks[1], (D_MODEL,), 0.02),
        'ln_in_b': nrm(ks[2], (D_MODEL,), 0.02),
        'w_in': nrm(ks[3], (L, D_MODEL, D_IN), D_MODEL ** -0.5),
        'g_q': 1.0 + nrm(ks[4], (L, Q_LORA_RANK), 0.02),
        'g_kv': 1.0 + nrm(ks[5], (L, KV_LORA_RANK), 0.02),
        'w_uq': nrm(ks[6], (L, Q_LORA_RANK, N_HEADS_MLA, QK_NOPE_DIM + QK_ROPE_DIM), Q_LORA_RANK ** -0.5),
        'w_ukv': nrm(ks[7], (L, KV_LORA_RANK, N_HEADS_MLA, QK_NOPE_DIM + V_HEAD_DIM), KV_LORA_RANK ** -0.5),
        'w_conv': nrm(ks[8], (L, CONV_WIDTH, D_CONV), CONV_WIDTH ** -0.5),
        'w_out': nrm(ks[9], (L, D_MIX, D_MODEL), DEEPNORM_BETA * D_MIX ** -0.5),
        'ln1_g': 1.0 + nrm(ks[10], (L, D_MODEL), 0.02),
        'ln1_b': nrm(ks[11], (L, D_MODEL), 0.02),
        'w_group': nrm(ks[12], (L, D_MODEL, N_EXPERT_GROUPS), D_MODEL ** -0.5),
        'b_group': nrm(ks[13], (L, N_EXPERT_GROUPS), 0.01),
        'w_router': nrm(ks[14], (L, D_MODEL, N_EXPERT_GROUPS, EXPERTS_PER_GROUP), D_MODEL ** -0.5),
        'b_router': nrm(ks[15], (L, N_EXPERT_GROUPS, EXPERTS_PER_GROUP), 0.01),
        'w_gate': nrm(ks[16], (L, N_EXPERT_GROUPS, EXPERTS_PER_GROUP, D_MODEL, D_EXPERT), D_MODEL ** -0.5),
        'w_up': nrm(ks[17], (L, N_EXPERT_GROUPS, EXPERTS_PER_GROUP, D_MODEL, D_EXPERT), D_MODEL ** -0.5),
        'w_down': nrm(ks[18], (L, N_EXPERT_GROUPS, EXPERTS_PER_GROUP, D_EXPERT, D_MODEL), DEEPNORM_BETA * D_EXPERT ** -0.5),
        'ln2_g': 1.0 + nrm(ks[19], (L, D_MODEL), 0.02),
        'ln2_b': nrm(ks[20], (L, D_MODEL), 0.02),
    }


def reference(x, ln_in_g, ln_in_b, w_in, g_q, g_kv, w_uq, w_ukv, w_conv, w_out, ln1_g, ln1_b,
              w_group, b_group, w_router, b_router, w_gate, w_up, w_down, ln2_g, ln2_b):
    cos, sin = rope_tables(x.shape[1], x.dtype)
    h = layer_norm(x, ln_in_g, ln_in_b)
    for l in range(DEPTH):
        mix = token_mixer(h, w_in[l], g_q[l], g_kv[l], w_uq[l], w_ukv[l], w_conv[l], w_out[l], cos, sin)
        h = layer_norm(DEEPNORM_ALPHA * h + mix, ln1_g[l], ln1_b[l])
        ffn = hier_moe(h, w_group[l], b_group[l], w_router[l], b_router[l], w_gate[l], w_up[l], w_down[l])
        h = layer_norm(DEEPNORM_ALPHA * h + ffn, ln2_g[l], ln2_b[l])
    return h
```

```cpp
#include <hip/hip_runtime.h>
#include <cstdio>
#include <cstdint>

#ifndef MK_PER_PHASE
#define MK_PER_PHASE 0
#endif

#ifndef PROBE_CHECK
#define PROBE_CHECK 0
#endif
#define GAS __attribute__((address_space(1)))
#define LAS __attribute__((address_space(3)))
typedef unsigned short bf16;
typedef unsigned v4u __attribute__((ext_vector_type(4)));
typedef unsigned v2u __attribute__((ext_vector_type(2)));
typedef float f32x4 __attribute__((ext_vector_type(4)));
typedef float f32x16 __attribute__((ext_vector_type(16)));
typedef short bf16x8 __attribute__((ext_vector_type(8)));
typedef short s16x4 __attribute__((ext_vector_type(4)));
typedef GAS unsigned gu32;
#define RLX_AGENT __ATOMIC_RELAXED, __HIP_MEMORY_SCOPE_AGENT
#define LDS_WAIT() asm volatile("s_waitcnt lgkmcnt(0)" ::: "memory")
#define VM_WAIT() asm volatile("s_waitcnt vmcnt(0)" ::: "memory")

constexpr int BATCH = 2, SEQ = 16384, DM = 1024, NTOK = BATCH * SEQ, DEPTH = 2;
constexpr int NH = 8, DNOPE = 64, DROPE = 32, DQK = 96, DV = 64, QLORA = 384, KVLORA = 256;
constexpr int DIN = 1696, ZLD = 2048;
constexpr int ZC_KPE = 640, ZC_B = 768, ZC_C = 1024, ZC_H = 1280, ZC_FR = 1536;
constexpr int NEXP = 32, DEXP = 256;
constexpr float LN_EPS = 1e-5f, RMS_EPS = 1e-6f;
constexpr float ALPHA = 1.4142135623730951f;
constexpr float QSCALE = 0.10206207261596577f * 1.4426950408889634f;
constexpr int MAXROWS = 73728;

constexpr size_t MiB = 1u << 20;
constexpr size_t WS_CTL = 0, CTL_ZERO_BYTES = 32 * 1024;
constexpr size_t WS_WIN = 1 * MiB;
constexpr size_t WS_WUQ = 9 * MiB;
constexpr size_t WS_WUKV = 11 * MiB;
constexpr size_t WS_WOUT = 13 * MiB;
constexpr size_t WS_WR = 17 * MiB;
constexpr size_t WS_WGU = 18 * MiB;
constexpr size_t WS_WD = 82 * MiB;
constexpr size_t WS_ROPE = 114 * MiB;
constexpr size_t WS_FA1 = 116 * MiB;
constexpr size_t WS_SSQ = 117 * MiB;
constexpr size_t WS_LG = 120 * MiB;
constexpr size_t WS_TOK = 128 * MiB;
constexpr size_t WS_CNTS = 128 * MiB + 512 * 1024;
constexpr size_t WS_ROWTOK = 129 * MiB;
constexpr size_t WS_H = 130 * MiB;
constexpr size_t WS_Z = 194 * MiB;
constexpr size_t WS_V = 338 * MiB;
constexpr size_t WS_O = 370 * MiB;
constexpr size_t WS_END = 434 * MiB;
constexpr size_t DO_Q = 0, DO_K = 48 * MiB, DO_U = 96 * MiB;
constexpr int CW_DIAG = 16, CW_DIAG2 = 17; constexpr int CW_TMO = 0, CW_BAR = 4096;
static_assert((CW_BAR + 3456) * 4 <= (int)CTL_ZERO_BYTES, "barrier words inside the per-call memset");

constexpr int RING_BYTES = 131072;
constexpr int LDSCTL_OFF = RING_BYTES, MISC_OFF = LDSCTL_OFF + 320;
constexpr int SEG_OFF = MISC_OFF + 128;
constexpr int RT_OFF = SEG_OFF + 512;
constexpr int LDS_BYTES = 147456;
static_assert(RT_OFF + 256 <= LDS_BYTES, "LDS map");
constexpr int NWAVES = 8;

__device__ __forceinline__ unsigned cvt_pk_bf16(float lo, float hi) { unsigned r; asm volatile("v_cvt_pk_bf16_f32 %0, %1, %2" : "=v"(r) : "v"(lo), "v"(hi)); return r; }
__device__ __forceinline__ float bf_lo(unsigned w) { return __uint_as_float(w << 16); }
__device__ __forceinline__ float bf_hi(unsigned w) { return __uint_as_float(w & 0xffff0000u); }
__device__ __forceinline__ float wave_sum(float v) {
#pragma unroll
    for (int o = 1; o < 64; o <<= 1) v += __shfl_xor(v, o);
    return v;
}

namespace pg8 {
typedef unsigned short bf16_t;
constexpr int BM = 256, BK = 64, HALF = 128, HTB = HALF * BK * 2, STAGE_BYTES = 8 * HTB;
__host__ __device__ __forceinline__ int lds_byte(int r, int c) { const int st = (r >> 4) * 2 + (c >> 5), rr = r & 15, cc = c & 31, ob = rr * 64 + cc * 2; return st * 1024 + (ob ^ (((ob >> 9) & 1) << 5)); }
__host__ __device__ __forceinline__ void stage_rc(int b, int& R, int& C) { const int st = b / 1024, sb = b % 1024, swz = sb ^ (((sb >> 9) & 1) << 5); R = (st >> 1) * 16 + swz / 64; C = (st & 1) * 32 + (swz % 64) / 2; }
__host__ __device__ __forceinline__ int perm32(int rho) { const int n = rho >> 4, i = rho & 15; return 8 * (i >> 2) + 4 * n + (i & 3); }

struct Unit { int pm, pn, e; };
struct Gemm { const bf16_t* A; const bf16_t* Bt; int lda, ldb, K; size_t estride; };

template <class Epi, class Sched>
__device__ __forceinline__ void gemm_phase(LAS unsigned char* lds, const Gemm g, const Sched& S, const Epi& E, const int tid) {
    const int wid = __builtin_amdgcn_readfirstlane(tid >> 6), lane = tid & 63, wr = wid >> 2, wc = wid & 3, fr = lane & 15, fq = lane >> 4;
    const int K = g.K, nt = K / BK;
    unsigned voffA[2], voffB[2];
#pragma unroll
    for (int i = 0; i < 2; ++i) { int R, C; stage_rc(tid * 16 + i * 8192, R, C); const int Rb = Epi::PERM ? ((R & ~31) + perm32(R & 31)) : R;
        voffA[i] = (unsigned)(R * g.lda + C) * 2u; voffB[i] = (unsigned)(Rb * g.ldb + C) * 2u; }
    const size_t kstep = (size_t)(BK * 2);
    const size_t hstepA = (size_t)HALF * g.lda * 2, hstepB = (size_t)HALF * g.ldb * 2;
    const size_t tstepA = 2 * hstepA, tstepB = 2 * hstepB;
    const unsigned ldsw = (unsigned)wid * 1024u;
    const int aoff = lds_byte(wr * 64 + fr, fq * 8), boff = lds_byte(wc * 32 + fr, fq * 8);
#define PG8_SA(b, h) (((b) * 2 + (h)) * HTB)
#define PG8_SB(b, h) ((4 + (b) * 2 + (h)) * HTB)
#define PG8_STAGE(bufoff, gbase, voff) do { _Pragma("unroll") for (int _i = 0; _i < 2; ++_i) \
        __builtin_amdgcn_global_load_lds((const unsigned*)((const char*)(gbase) + (voff)[_i]), (LAS unsigned*)(lds + (bufoff) + ldsw + _i * 8192), 16, 0, 0); } while (0)
#define PG8_LDA(dst, b, h) do { _Pragma("unroll") for (int m = 0; m < 4; ++m) _Pragma("unroll") for (int k = 0; k < 2; ++k) dst[m][k] = *(const LAS bf16x8*)(lds + PG8_SA(b, h) + aoff + m * 2048 + k * 1024); } while (0)
#define PG8_LDB(dst, b, h) do { _Pragma("unroll") for (int n = 0; n < 2; ++n) _Pragma("unroll") for (int k = 0; k < 2; ++k) dst[n][k] = *(const LAS bf16x8*)(lds + PG8_SB(b, h) + boff + n * 2048 + k * 1024); } while (0)
#define PG8_MMA(ai, bj, At, Bt) do { __builtin_amdgcn_s_setprio(1); _Pragma("unroll") for (int m = 0; m < 4; ++m) _Pragma("unroll") for (int n = 0; n < 2; ++n) _Pragma("unroll") for (int k = 0; k < 2; ++k) \
        acc[ai][bj][m][n] = __builtin_amdgcn_mfma_f32_16x16x32_bf16(Bt[n][k], At[m][k], acc[ai][bj][m][n], 0, 0, 0); __builtin_amdgcn_s_setprio(0); } while (0)
#define PG8_WAIT_V(n) asm volatile("s_waitcnt vmcnt(" #n ")" ::: "memory")
#define PG8_WAIT_L(n) asm volatile("s_waitcnt lgkmcnt(" #n ")" ::: "memory")
#define PG8_BAR __builtin_amdgcn_s_barrier()
#define PG8_SCHED __builtin_amdgcn_sched_barrier(0)
    Unit cur, nxt; int ui = 0;
    if (!S.next(0, cur)) return;
    f32x4 acc[2][2][4][2];
#pragma unroll
    for (int a = 0; a < 2; ++a)
#pragma unroll
        for (int b = 0; b < 2; ++b)
#pragma unroll
            for (int m = 0; m < 4; ++m)
#pragma unroll
                for (int n = 0; n < 2; ++n) acc[a][b][m][n] = (f32x4){0.f, 0.f, 0.f, 0.f};
    bf16x8 At[4][2], B0[2][2], B1[2][2];
    const char* cA = (const char*)g.A + (size_t)cur.pm * tstepA; const char* cB = (const char*)g.Bt + (size_t)cur.e * g.estride + (size_t)cur.pn * tstepB;
    PG8_STAGE(PG8_SB(0, 0), cB, voffB); PG8_STAGE(PG8_SB(0, 1), cB + hstepB, voffB); PG8_STAGE(PG8_SA(0, 0), cA, voffA); PG8_STAGE(PG8_SA(0, 1), cA + hstepA, voffA);
    if (wr == 1) PG8_BAR;
    PG8_WAIT_V(2); PG8_BAR;
    PG8_STAGE(PG8_SB(1, 0), cB + kstep, voffB); PG8_STAGE(PG8_SA(1, 0), cA + kstep, voffA); PG8_STAGE(PG8_SB(1, 1), cB + hstepB + kstep, voffB);
    PG8_WAIT_V(6); PG8_BAR;
    for (;;) {
        const bool has_next = S.next(ui + 1, nxt);
        const char* nA = has_next ? (const char*)g.A + (size_t)nxt.pm * tstepA : cA;
        const char* nB = has_next ? (const char*)g.Bt + (size_t)nxt.e * g.estride + (size_t)nxt.pn * tstepB : cB;
#pragma unroll 1
        for (int t = 0; t < nt; t += 2) {
            const bool last = (t == nt - 2);
            const char* a1 = cA + (size_t)(t + 1) * kstep;
            const char* a2 = last ? nA : cA + (size_t)(t + 2) * kstep; const char* b2 = last ? nB : cB + (size_t)(t + 2) * kstep;
            const char* a3 = a2 + kstep; const char* b3 = b2 + kstep;
            PG8_LDB(B0, 0, 0); PG8_LDB(B1, 0, 1); PG8_SCHED; PG8_LDA(At, 0, 0); PG8_STAGE(PG8_SA(1, 1), a1 + hstepA, voffA);
            PG8_WAIT_V(8); PG8_WAIT_L(0); PG8_BAR; PG8_MMA(0, 0, At, B0); PG8_MMA(0, 1, At, B1); PG8_BAR; PG8_SCHED;
            PG8_LDA(At, 0, 1); PG8_STAGE(PG8_SB(0, 0), b2, voffB); PG8_STAGE(PG8_SB(0, 1), b2 + hstepB, voffB); PG8_STAGE(PG8_SA(0, 0), a2, voffA);
            PG8_WAIT_V(8); PG8_WAIT_L(0); PG8_BAR; PG8_MMA(1, 0, At, B0); PG8_MMA(1, 1, At, B1); PG8_BAR; PG8_SCHED;
            PG8_LDB(B0, 1, 0); PG8_LDB(B1, 1, 1); PG8_SCHED; PG8_LDA(At, 1, 0); PG8_STAGE(PG8_SA(0, 1), a2 + hstepA, voffA);
            PG8_WAIT_V(8); PG8_WAIT_L(0); PG8_BAR; PG8_MMA(0, 0, At, B0); PG8_MMA(0, 1, At, B1); PG8_BAR; PG8_SCHED;
            PG8_LDA(At, 1, 1); PG8_STAGE(PG8_SB(1, 0), b3, voffB); PG8_STAGE(PG8_SB(1, 1), b3 + hstepB, voffB); PG8_STAGE(PG8_SA(1, 0), a3, voffA);
            PG8_WAIT_V(8); PG8_WAIT_L(0); PG8_BAR; PG8_MMA(1, 0, At, B0); PG8_MMA(1, 1, At, B1); PG8_BAR; PG8_SCHED;
        }
        if (wr == 0) PG8_BAR;
        E(acc, cur, wr, wc, fr, fq);
        if (!has_next) break;
#pragma unroll
        for (int a = 0; a < 2; ++a)
#pragma unroll
            for (int b = 0; b < 2; ++b)
#pragma unroll
                for (int m = 0; m < 4; ++m)
#pragma unroll
                    for (int n = 0; n < 2; ++n) acc[a][b][m][n] = (f32x4){0.f, 0.f, 0.f, 0.f};
        cur = nxt; cA = nA; cB = nB; ++ui;
        if (wr == 1) PG8_BAR;
    }
    PG8_WAIT_V(0);
    PG8_BAR;
#undef PG8_SA
#undef PG8_SB
#undef PG8_STAGE
#undef PG8_LDA
#undef PG8_LDB
#undef PG8_MMA
#undef PG8_WAIT_V
#undef PG8_WAIT_L
#undef PG8_BAR
#undef PG8_SCHED
}

struct LinOrder {
    int nN, total, G, c;
    __device__ __forceinline__ bool next(int i, Unit& u) const { const int L = i * G + c; if (L >= total) return false; u.pm = L / nN; u.pn = L - u.pm * nN; u.e = 0; return true; }
};
struct KvOrder {
    int G, c;
    __device__ __forceinline__ bool next(int i, Unit& u) const {
        int L;
        if (G != 256) { L = i * G + c; if (L >= 512) return false; }
        else if (c < 128) { if (i > 0) return false; L = c; }
        else { if (i > 2) return false; L = 128 + (c - 128) * 3 + i; }
        u.pm = L >> 2; u.pn = L & 3; u.e = 0; return true; }
};
struct MoeOrder {
    int nN, total, G, c; const LAS int* seg;
    __device__ __forceinline__ bool next(int i, Unit& u) const { const int L = i * G + c; if (L >= total) return false; u.pm = L / nN; u.pn = L - u.pm * nN;
        int e = 0;
#pragma unroll 1
        for (int j = 1; j < NEXP; ++j) e += (seg[j] <= u.pm) ? 1 : 0;
        u.e = e; return true; }
};
}

typedef float f32x2 __attribute__((ext_vector_type(2)));
typedef const f32x4 (&AccRef)[2][2][4][2];
#define EPI_FENCE() do { asm volatile("" ::: "memory"); __builtin_amdgcn_sched_barrier(0); } while (0)
struct EpiZ { static constexpr bool PERM = true;
    bf16* Z; float* ssq;
    __device__ __forceinline__ void operator()(AccRef acc, const pg8::Unit& u, int wr, int wc, int fr, int fq) const {
        const int row0 = u.pm * 256 + wr * 64 + fr, col0 = u.pn * 256 + wc * 32 + 8 * fq;
#pragma unroll
        for (int ai = 0; ai < 2; ++ai)
#pragma unroll
            for (int m = 0; m < 4; ++m) { const int row = row0 + ai * 128 + m * 16; bf16* rowp = Z + (size_t)row * ZLD + col0;
#pragma unroll
                for (int bj = 0; bj < 2; ++bj) { const f32x4 v0 = acc[ai][bj][m][0], v1 = acc[ai][bj][m][1];
                    v4u w; w.x = cvt_pk_bf16(v0[0], v0[1]); w.y = cvt_pk_bf16(v0[2], v0[3]); w.z = cvt_pk_bf16(v1[0], v1[1]); w.w = cvt_pk_bf16(v1[2], v1[3]);
                    *(v4u*)(rowp + bj * 128) = w;
                    const int grp = 2 * u.pn + bj;
                    if (grp < 5) { float s = (v0[0] * v0[0] + v0[1] * v0[1]) + (v0[2] * v0[2] + v0[3] * v0[3]) + (v1[0] * v1[0] + v1[1] * v1[1]) + (v1[2] * v1[2] + v1[3] * v1[3]);
                        s += __shfl_xor(s, 16); s += __shfl_xor(s, 32);
                        if (fq == 0) ssq[(size_t)row * 20 + grp * 4 + wc] = s; } } EPI_FENCE(); }
    }
};
__device__ __forceinline__ float ssq_sum(const float* p, int n4) { float s = 0.f; for (int i = 0; i < n4; ++i) { const f32x4 v = *(const f32x4*)(p + 4 * i); s += (v[0] + v[1]) + (v[2] + v[3]); } return s; }
struct EpiQ { static constexpr bool PERM = true;
    bf16* Q; const float* ssq;
    __device__ __forceinline__ void operator()(AccRef acc, const pg8::Unit& u, int wr, int wc, int fr, int fq) const {
        const int row0 = u.pm * 256 + wr * 64 + fr;
        float rq[8];
#pragma unroll
        for (int i = 0; i < 8; ++i) { const float* p = ssq + (size_t)(row0 + (i >> 2) * 128 + (i & 3) * 16) * 20 + 3 * fq; rq[i] = (p[0] + p[1]) + p[2]; }
#pragma unroll
        for (int i = 0; i < 8; ++i) { float s = rq[i]; s += __shfl_xor(s, 16); s += __shfl_xor(s, 32); rq[i] = QSCALE / sqrtf(s * (1.0f / QLORA) + RMS_EPS); }
#pragma unroll
        for (int ai = 0; ai < 2; ++ai)
#pragma unroll
            for (int m = 0; m < 4; ++m) { const int row = row0 + ai * 128 + m * 16, b = row / SEQ, s = row - b * SEQ; const float r = rq[ai * 4 + m];
#pragma unroll
                for (int bj = 0; bj < 2; ++bj) { const int c32 = 8 * u.pn + 4 * bj + wc, head = c32 / 3, part = c32 - 3 * head;
                    const f32x4 v0 = acc[ai][bj][m][0] * r, v1 = acc[ai][bj][m][1] * r;
                    v4u w; w.x = cvt_pk_bf16(v0[0], v0[1]); w.y = cvt_pk_bf16(v0[2], v0[3]); w.z = cvt_pk_bf16(v1[0], v1[1]); w.w = cvt_pk_bf16(v1[2], v1[3]);
                    *(v4u*)(Q + ((size_t)(b * NH + head) * SEQ + s) * DQK + part * 32 + 8 * fq) = w; } }
    }
};
struct EpiKV { static constexpr bool PERM = true;
    bf16* Kb; bf16* Vb; const bf16* Z; const float* ssq; const float* rcos; const float* rsin; int tid_;
    __device__ __forceinline__ void operator()(AccRef acc, const pg8::Unit& u, int wr, int wc, int fr, int fq) const {
        const int row0 = u.pm * 256 + wr * 64 + fr;
        float rk[8];
#pragma unroll
        for (int i = 0; i < 8; ++i) { const float* p = ssq + (size_t)(row0 + (i >> 2) * 128 + (i & 3) * 16) * 20 + 12 + 2 * fq; rk[i] = p[0] + p[1]; }
#pragma unroll
        for (int i = 0; i < 8; ++i) { float s = rk[i]; s += __shfl_xor(s, 16); s += __shfl_xor(s, 32); rk[i] = 1.0f / sqrtf(s * (1.0f / KVLORA) + RMS_EPS); }
#pragma unroll
        for (int ai = 0; ai < 2; ++ai)
#pragma unroll
            for (int m = 0; m < 4; ++m) { const int row = row0 + ai * 128 + m * 16, b = row / SEQ, s = row - b * SEQ; const float r = rk[ai * 4 + m];
#pragma unroll
                for (int bj = 0; bj < 2; ++bj) { const int col = 256 * u.pn + 128 * bj + 32 * wc + 8 * fq;
                    const f32x4 v0 = acc[ai][bj][m][0] * r, v1 = acc[ai][bj][m][1] * r;
                    v4u w; w.x = cvt_pk_bf16(v0[0], v0[1]); w.y = cvt_pk_bf16(v0[2], v0[3]); w.z = cvt_pk_bf16(v1[0], v1[1]); w.w = cvt_pk_bf16(v1[2], v1[3]);
                    if (col < 512) { const int head = col >> 6, d = col & 63; *(v4u*)(Kb + ((size_t)(b * NH + head) * SEQ + s) * DQK + d) = w; }
                    else { const int c2 = col - 512, head = c2 >> 6, d = c2 & 63; *(v4u*)(Vb + ((size_t)(b * NH + head) * SEQ + s) * DV + d) = w; } } }
        if (u.pn < 2) {
            const int tid = tid_, row = u.pm * 256 + (tid >> 1), jh = tid & 1, b = row / SEQ, s = row - b * SEQ;
            const v4u t1 = *(const v4u*)(Z + (size_t)row * ZLD + ZC_KPE + 8 * jh), t2 = *(const v4u*)(Z + (size_t)row * ZLD + ZC_KPE + 16 + 8 * jh);
            const f32x4 c0 = *(const f32x4*)(rcos + (size_t)s * 16 + 8 * jh), c1 = *(const f32x4*)(rcos + (size_t)s * 16 + 8 * jh + 4), s0 = *(const f32x4*)(rsin + (size_t)s * 16 + 8 * jh), s1 = *(const f32x4*)(rsin + (size_t)s * 16 + 8 * jh + 4);
            float a[8], c[8];
#pragma unroll
            for (int i = 0; i < 4; ++i) { a[2 * i] = bf_lo(t1[i]); a[2 * i + 1] = bf_hi(t1[i]); c[2 * i] = bf_lo(t2[i]); c[2 * i + 1] = bf_hi(t2[i]); }
            float o1[8], o2[8];
#pragma unroll
            for (int i = 0; i < 8; ++i) { const float cs = i < 4 ? c0[i] : c1[i - 4], sn = i < 4 ? s0[i] : s1[i - 4]; o1[i] = a[i] * cs - c[i] * sn; o2[i] = a[i] * sn + c[i] * cs; }
            v4u w1, w2; w1.x = cvt_pk_bf16(o1[0], o1[1]); w1.y = cvt_pk_bf16(o1[2], o1[3]); w1.z = cvt_pk_bf16(o1[4], o1[5]); w1.w = cvt_pk_bf16(o1[6], o1[7]);
            w2.x = cvt_pk_bf16(o2[0], o2[1]); w2.y = cvt_pk_bf16(o2[2], o2[3]); w2.z = cvt_pk_bf16(o2[4], o2[5]); w2.w = cvt_pk_bf16(o2[6], o2[7]);
#pragma unroll
            for (int hh = 0; hh < 4; ++hh) { bf16* kp = Kb + ((size_t)(b * NH + 4 * u.pn + hh) * SEQ + s) * DQK + 64 + 8 * jh; *(v4u*)kp = w1; *(v4u*)(kp + 16) = w2; }
        }
    }
};
struct EpiOut { static constexpr bool PERM = true;
    bf16* Y;
    __device__ __forceinline__ void operator()(AccRef acc, const pg8::Unit& u, int wr, int wc, int fr, int fq) const {
        const int row0 = u.pm * 256 + wr * 64 + fr, col0 = u.pn * 256 + wc * 32 + 8 * fq;
#pragma unroll
        for (int ai = 0; ai < 2; ++ai)
#pragma unroll
            for (int m = 0; m < 4; ++m) { bf16* rowp = Y + (size_t)(row0 + ai * 128 + m * 16) * DM + col0;
#pragma unroll
                for (int bj = 0; bj < 2; ++bj) { const f32x4 v0 = acc[ai][bj][m][0], v1 = acc[ai][bj][m][1];
                    v4u w; w.x = cvt_pk_bf16(v0[0], v0[1]); w.y = cvt_pk_bf16(v0[2], v0[3]); w.z = cvt_pk_bf16(v1[0], v1[1]); w.w = cvt_pk_bf16(v1[2], v1[3]);
                    *(v4u*)(rowp + bj * 128) = w; } }
    }
};
struct EpiLogits { static constexpr bool PERM = false;
    float* LG;
    __device__ __forceinline__ void operator()(AccRef acc, const pg8::Unit& u, int wr, int wc, int fr, int fq) const {
        if (wc >= 2) return;
        const int row0 = u.pm * 256 + wr * 64 + fr;
#pragma unroll
        for (int ai = 0; ai < 2; ++ai)
#pragma unroll
            for (int m = 0; m < 4; ++m) { const int row = row0 + ai * 128 + m * 16;
#pragma unroll
                for (int n = 0; n < 2; ++n) *(f32x4*)(LG + (size_t)row * 64 + 32 * wc + 16 * n + 4 * fq) = acc[ai][0][m][n]; }
    }
};
struct EpiGU { static constexpr bool PERM = true;
    bf16* HID; const float* roww;
    __device__ __forceinline__ void operator()(AccRef acc, const pg8::Unit& u, int wr, int wc, int fr, int fq) const {
        const int row0 = u.pm * 256 + wr * 64 + fr, col0 = u.pn * 128 + wc * 32 + 8 * fq;
        float wv[8];
#pragma unroll
        for (int i = 0; i < 8; ++i) wv[i] = roww[row0 + (i >> 2) * 128 + (i & 3) * 16];
#pragma unroll
        for (int ai = 0; ai < 2; ++ai)
#pragma unroll
            for (int m = 0; m < 4; ++m) { const int row = row0 + ai * 128 + m * 16; const float w = wv[ai * 4 + m];
                float o[8];
#pragma unroll
                for (int n = 0; n < 2; ++n)
#pragma unroll
                    for (int i = 0; i < 4; ++i) { const float gt = acc[ai][0][m][n][i], up = acc[ai][1][m][n][i];
                        const float sg = gt * __builtin_amdgcn_rcpf(1.0f + __builtin_amdgcn_exp2f(-1.4426950408889634f * gt)); o[4 * n + i] = sg * up * w; }
                v4u pk; pk.x = cvt_pk_bf16(o[0], o[1]); pk.y = cvt_pk_bf16(o[2], o[3]); pk.z = cvt_pk_bf16(o[4], o[5]); pk.w = cvt_pk_bf16(o[6], o[7]);
                *(v4u*)(HID + (size_t)row * DEXP + col0) = pk; EPI_FENCE(); }
    }
};
struct EpiDown { static constexpr bool PERM = true;
    bf16* PARTS; const int* rowtok;
    __device__ __forceinline__ void operator()(AccRef acc, const pg8::Unit& u, int wr, int wc, int fr, int fq) const {
        const int row0 = u.pm * 256 + wr * 64 + fr, col0 = u.pn * 256 + wc * 32 + 8 * fq;
        int dv[8];
#pragma unroll
        for (int i = 0; i < 8; ++i) dv[i] = rowtok[row0 + (i >> 2) * 128 + (i & 3) * 16];
#pragma unroll
        for (int ai = 0; ai < 2; ++ai)
#pragma unroll
            for (int m = 0; m < 4; ++m) { const int dst = dv[ai * 4 + m];
                if (dst >= 0) {
#pragma unroll
                    for (int bj = 0; bj < 2; ++bj) { const f32x4 v0 = acc[ai][bj][m][0], v1 = acc[ai][bj][m][1];
                        v4u w; w.x = cvt_pk_bf16(v0[0], v0[1]); w.y = cvt_pk_bf16(v0[2], v0[3]); w.z = cvt_pk_bf16(v1[0], v1[1]); w.w = cvt_pk_bf16(v1[2], v1[3]);
                        *(v4u*)(PARTS + (size_t)dst * DM + col0 + bj * 128) = w; } } EPI_FENCE(); }
    }
};

namespace att {
constexpr int KVBLK = 64;
constexpr int SHM_K = KVBLK * 256, SHM_V = KVBLK * DV * 2;
constexpr int ATT_LDS = 5 * SHM_K + 5 * SHM_V + NWAVES * 64 * 4;
static_assert(ATT_LDS <= RING_BYTES, "attention LDS");
#define KSWZ(row, colB) ((row) * 256 + ((colB) ^ (((row) & 15) << 4)))
#define SBAR() __builtin_amdgcn_sched_barrier(0)
__device__ __forceinline__ int crow(int r, int hi) { return (r & 3) + 8 * (r >> 2) + 4 * hi; }
#ifndef ATT_REF0_MIN
#define ATT_REF0_MIN -40.0f
#endif
#ifndef ATT_OVF
#define ATT_OVF 1e18f
#endif
__device__ __forceinline__ void expP0(f32x16& p0) {
#pragma unroll
    for (int r = 0; r < 16; ++r) p0[r] = __builtin_amdgcn_exp2f(p0[r]);
}
__device__ __forceinline__ float expP1sum(f32x16& p0, f32x16& p1) {
#pragma unroll
    for (int r = 0; r < 16; ++r) p1[r] = __builtin_amdgcn_exp2f(p1[r]);
    float ps = 0;
#pragma unroll
    for (int r = 0; r < 16; ++r) ps += p0[r];
#pragma unroll
    for (int r = 0; r < 16; ++r) ps += p1[r];
    return ps;
}
__device__ __forceinline__ void cvtP(const f32x16& p0, const f32x16& p1, bf16x8& pa0, bf16x8& pa1, bf16x8& pa2, bf16x8& pa3) {
#define PK8(P, BASE, OUT) do { v4u w = {cvt_pk_bf16(P[BASE + 0], P[BASE + 1]), cvt_pk_bf16(P[BASE + 2], P[BASE + 3]), cvt_pk_bf16(P[BASE + 4], P[BASE + 5]), cvt_pk_bf16(P[BASE + 6], P[BASE + 7])}; OUT = *reinterpret_cast<bf16x8*>(&w); } while (0)
    PK8(p0, 0, pa0); PK8(p0, 8, pa1); PK8(p1, 0, pa2); PK8(p1, 8, pa3);
#undef PK8
}
__device__ __forceinline__ float rowmax32(const f32x16& p0, const f32x16& p1) {
    float pmax = p0[0];
#pragma unroll
    for (int r = 1; r < 16; ++r) pmax = fmaxf(pmax, p0[r]);
#pragma unroll
    for (int r = 0; r < 16; ++r) pmax = fmaxf(pmax, p1[r]);
    auto rr = __builtin_amdgcn_permlane32_swap(__float_as_uint(pmax), __float_as_uint(pmax), false, false);
    return fmaxf(__uint_as_float(rr[0]), __uint_as_float(rr[1]));
}
__device__ __forceinline__ void qkt(f32x16& p0, f32x16& p1, const char* Ks, const bf16x8* qr, const f32x16& init, int r32, int hi) {
#pragma unroll
    for (int d0 = 0; d0 < 6; ++d0) { const int cb = (d0 * 16 + hi * 8) * 2;
        const bf16x8 b0 = *reinterpret_cast<const bf16x8*>(Ks + KSWZ(r32, cb));
        const bf16x8 b1 = *reinterpret_cast<const bf16x8*>(Ks + KSWZ(32 + r32, cb));
        p0 = __builtin_amdgcn_mfma_f32_32x32x16_bf16(b0, qr[d0], d0 == 0 ? init : p0, 0, 0, 0);
        p1 = __builtin_amdgcn_mfma_f32_32x32x16_bf16(b1, qr[d0], d0 == 0 ? init : p1, 0, 0, 0); }
}
__device__ __forceinline__ int v_st(int k, int c) { const int kk = (k & ~0xC) | ((k & 4) << 1) | ((k & 8) >> 1); return ((kk >> 3) * 2 + (c >> 5)) * 512 + ((kk & 7) * 32 + (c & 31)) * 2; }
__device__ __forceinline__ int att_v_rd_base(int lane) { return ((lane & 3) << 3) | (((lane >> 2) & 3) << 6) | (((lane >> 4) & 1) << 5) | (((lane >> 5) & 1) << 10); }
constexpr int att_v_rd_off(int d0, int ks, int half) { return d0 * 512 + ks * 2048 + half * 256; }
__device__ __forceinline__ int v_rd_base(int lane) { return ((lane & 3) << 3) | (((lane >> 2) & 3) << 6) | (((lane >> 4) & 1) << 5) | (((lane >> 5) & 1) << 8); }
constexpr int v_rd_off(int d0, int ks, int half) { return d0 * 512 + ks * 2048 + half * 1024; }
template <int OFF> __device__ __forceinline__ s16x4 tr_read(int vb) {
    s16x4 r; asm volatile("ds_read_b64_tr_b16 %0, %1 offset:%2" : "=&v"(r) : "v"(vb), "i"(OFF) : "memory"); return r;
}
template <int D0> __device__ __forceinline__ void pv_one(f32x16& od, int vb, bf16x8 pa0, bf16x8 pa1, bf16x8 pa2, bf16x8 pa3) {
    const s16x4 l0 = tr_read<v_rd_off(D0, 0, 0)>(vb), h0 = tr_read<v_rd_off(D0, 0, 1)>(vb), l1 = tr_read<v_rd_off(D0, 1, 0)>(vb), h1 = tr_read<v_rd_off(D0, 1, 1)>(vb);
    const s16x4 l2 = tr_read<v_rd_off(D0, 2, 0)>(vb), h2 = tr_read<v_rd_off(D0, 2, 1)>(vb), l3 = tr_read<v_rd_off(D0, 3, 0)>(vb), h3 = tr_read<v_rd_off(D0, 3, 1)>(vb);
    asm volatile("s_waitcnt lgkmcnt(0)" ::: "memory"); SBAR();
#define PK(L, H) (bf16x8){L[0], L[1], L[2], L[3], H[0], H[1], H[2], H[3]}
    od = __builtin_amdgcn_mfma_f32_32x32x16_bf16(pa0, PK(l0, h0), od, 0, 0, 0);
    od = __builtin_amdgcn_mfma_f32_32x32x16_bf16(pa1, PK(l1, h1), od, 0, 0, 0);
    od = __builtin_amdgcn_mfma_f32_32x32x16_bf16(pa2, PK(l2, h2), od, 0, 0, 0);
    od = __builtin_amdgcn_mfma_f32_32x32x16_bf16(pa3, PK(l3, h3), od, 0, 0, 0);
#undef PK
}
__device__ __forceinline__ void pv_d0(f32x16* o, int vb, bf16x8 pa0, bf16x8 pa1, bf16x8 pa2, bf16x8 pa3) {
    pv_one<0>(o[0], vb, pa0, pa1, pa2, pa3); pv_one<1>(o[1], vb, pa0, pa1, pa2, pa3);
}
typedef short v4i16_t __attribute__((ext_vector_type(4)));
__device__ __forceinline__ s16x4 vtr(const LAS char* p) { return __builtin_bit_cast(s16x4, __builtin_amdgcn_ds_read_tr16_b64_v4i16((LAS v4i16_t*)p)); }
constexpr int KRING = 5, VRING = 5, LDS_KR = 0, LDS_VR = KRING * SHM_K, LDS_WSF = LDS_VR + VRING * SHM_V;
__device__ __forceinline__ void attn_unit(const bf16* __restrict__ Qb, const bf16* __restrict__ Kh, const bf16* __restrict__ Vh, bf16* __restrict__ Ob, LAS char* lds, const int tid, const float* __restrict__ rcos, const float* __restrict__ rsin, const int spos0) {
    const int wid = __builtin_amdgcn_readfirstlane(tid >> 6), lane = tid & 63, r32 = lane & 31, hi = lane >> 5; const bool g1 = wid >= 4;
    LAS float* wsf = (LAS float*)(lds + LDS_WSF) + wid * 64; LAS float* li_l = wsf; LAS float* al_l = wsf + 32;
    unsigned koff[2];
#pragma unroll
    for (int i = 0; i < 2; ++i) { const int inst = wid + 8 * i, row = 4 * inst + (lane >> 4), phys = lane & 15; int logi = phys ^ (row & 15); if (logi >= 12) logi -= 8; koff[i] = (unsigned)(row * DQK + logi * 8) * 2u; }
    unsigned voff; { const int q16 = 64 * wid + lane, sub = q16 >> 5, within = q16 & 31, kk = ((sub >> 1) << 3) | (within >> 2), k = (kk & ~0xC) | ((kk & 4) << 1) | ((kk & 8) >> 1), c = (sub & 1) * 32 + (within & 3) * 8; voff = (unsigned)(k * DV + c) * 2u; }
    const char* Kg = (const char*)Kh; const char* Vg = (const char*)Vh;
#define DMA_K(t, slot) do { _Pragma("unroll") for (int i_ = 0; i_ < 2; ++i_) __builtin_amdgcn_global_load_lds((const unsigned*)(Kg + (size_t)(t) * (KVBLK * DQK * 2) + koff[i_]), (LAS unsigned*)(lds + LDS_KR + (slot) * SHM_K + (wid + 8 * i_) * 1024), 16, 0, 0); } while (0)
#define DMA_V(t, slot) __builtin_amdgcn_global_load_lds((const unsigned*)(Vg + (size_t)(t) * (KVBLK * DV * 2) + voff), (LAS unsigned*)(lds + LDS_VR + (slot) * SHM_V + wid * 1024), 16, 0, 0)
    DMA_K(0, 0); DMA_K(1, 1); DMA_K(2, 2); DMA_K(3, 3); DMA_V(0, 0); DMA_V(1, 1);
    float lacc = 0; f32x16 o[2] = {}; bf16x8 qr[6];
    const bf16* Qw = Qb + (size_t)(wid * 32 + r32) * DQK + hi * 8;
#pragma unroll
    for (int d0 = 0; d0 < 6; ++d0) qr[d0] = *reinterpret_cast<const bf16x8*>(Qw + d0 * 16);
    {
        const size_t to = (size_t)(spos0 + wid * 32 + r32) * 16 + 8 * hi;
        const f32x4 c0 = *(const f32x4*)(rcos + to), c1 = *(const f32x4*)(rcos + to + 4), s0 = *(const f32x4*)(rsin + to), s1 = *(const f32x4*)(rsin + to + 4);
        const v4u t1 = __builtin_bit_cast(v4u, qr[4]), t2 = __builtin_bit_cast(v4u, qr[5]); v4u o1, o2;
#pragma unroll
        for (int i = 0; i < 4; ++i) { const float ca = i < 2 ? c0[2 * i] : c1[2 * i - 4], cb = i < 2 ? c0[2 * i + 1] : c1[2 * i - 3], sa = i < 2 ? s0[2 * i] : s1[2 * i - 4], sb = i < 2 ? s0[2 * i + 1] : s1[2 * i - 3];
            const float a0 = bf_lo(t1[i]), a1 = bf_hi(t1[i]), b0 = bf_lo(t2[i]), b1 = bf_hi(t2[i]);
            o1[i] = cvt_pk_bf16(a0 * ca - b0 * sa, a1 * cb - b1 * sb); o2[i] = cvt_pk_bf16(a0 * sa + b0 * ca, a1 * sb + b1 * cb); }
        qr[4] = __builtin_bit_cast(bf16x8, o1); qr[5] = __builtin_bit_cast(bf16x8, o2); }
    int kro[6];
#pragma unroll
    for (int d0 = 0; d0 < 6; ++d0) kro[d0] = KSWZ(r32, (d0 * 16 + hi * 8) * 2);
    const int vro = att_v_rd_base(lane);
    bf16x8 kf[6][2]; s16x4 vl[2][4], vh[2][4];
#define KLOAD(slot) do { const LAS char* kb_ = lds + LDS_KR + (slot) * SHM_K; _Pragma("unroll") for (int d0 = 0; d0 < 6; ++d0) { kf[d0][0] = *(const LAS bf16x8*)(kb_ + kro[d0]); kf[d0][1] = *(const LAS bf16x8*)(kb_ + kro[d0] + 32 * 256); } } while (0)
#define VLOAD(slot, d0) do { const LAS char* vb_ = lds + LDS_VR + (slot) * SHM_V + vro; _Pragma("unroll") for (int ks = 0; ks < 4; ++ks) { vl[d0][ks] = vtr(vb_ + att_v_rd_off(d0, ks, 0)); vh[d0][ks] = vtr(vb_ + att_v_rd_off(d0, ks, 1)); } } while (0)
#define QKSTEP(d0, INIT) do { p0 = __builtin_amdgcn_mfma_f32_32x32x16_bf16(kf[d0][0], qr[d0], (d0) == 0 ? (INIT) : p0, 0, 0, 0); p1 = __builtin_amdgcn_mfma_f32_32x32x16_bf16(kf[d0][1], qr[d0], (d0) == 0 ? (INIT) : p1, 0, 0, 0); } while (0)
#define QKF(INIT) do { _Pragma("unroll") for (int d0 = 0; d0 < 6; ++d0) { p0 = __builtin_amdgcn_mfma_f32_32x32x16_bf16(kf[d0][0], qr[d0], d0 == 0 ? (INIT) : p0, 0, 0, 0); p1 = __builtin_amdgcn_mfma_f32_32x32x16_bf16(kf[d0][1], qr[d0], d0 == 0 ? (INIT) : p1, 0, 0, 0); } } while (0)
#define VFR(d0, ks) (bf16x8){vl[d0][ks][0], vl[d0][ks][1], vl[d0][ks][2], vl[d0][ks][3], vh[d0][ks][0], vh[d0][ks][1], vh[d0][ks][2], vh[d0][ks][3]}
#define NEXT5(x) (((x) == KRING - 1) ? 0 : (x) + 1)
#define NEXT3(x) (((x) == VRING - 1) ? 0 : (x) + 1)
    f32x16 p0, p1; float nm  ; const f32x16 zero16 = {}; bf16x8 pa0, pa1, pa2, pa3; constexpr int NT = SEQ / KVBLK;
    asm volatile("s_waitcnt vmcnt(0)" ::: "memory"); __builtin_amdgcn_s_barrier(); SBAR();
    bool slow; KLOAD(0); QKF(zero16); { const float m0_ = rowmax32(p0, p1); slow = __any(!(m0_ >= ATT_REF0_MIN)) != 0; nm = 0.f;
    if (slow) {
#pragma unroll
    for (int r = 0; r < 16; ++r) { p0[r] -= m0_; p1[r] -= m0_; } nm = -m0_; } }
    SBAR(); KLOAD(1); SBAR();
    if (g1) __builtin_amdgcn_s_barrier();
    int ks_cur = 0, ks_ld = 2, ks_dma = 4, vs = 0, vs_dma = 2;
    const char* kp = Kg + (size_t)4 * (KVBLK * DQK * 2); const char* vp = Vg + (size_t)2 * (KVBLK * DV * 2);
    unsigned kd = (unsigned)(LDS_KR + 4 * SHM_K) + (unsigned)wid * 1024u, vd = (unsigned)(LDS_VR + 2 * SHM_V) + (unsigned)wid * 1024u;
    int j = 0;
#define DMA_NEXT() do { asm volatile("" : "+v"(koff[0]), "+v"(koff[1]), "+v"(voff)); const unsigned k0_ = koff[0], k1_ = koff[1], v0_ = voff;     \
          __builtin_amdgcn_global_load_lds((const unsigned*)(kp + k0_), (LAS unsigned*)(lds + kd), 16, 0, 0); \
          __builtin_amdgcn_global_load_lds((const unsigned*)(kp + k1_), (LAS unsigned*)(lds + kd + 8192), 16, 0, 0); \
          __builtin_amdgcn_global_load_lds((const unsigned*)(vp + v0_), (LAS unsigned*)(lds + vd), 16, 0, 0); } while (0)
    auto reref = [&]() __attribute__((always_inline)) {
        const LAS char* kb_ = lds + LDS_KR + ks_cur * SHM_K;
#pragma unroll
        for (int d0 = 0; d0 < 6; ++d0) { const bf16x8 b0 = *(const LAS bf16x8*)(kb_ + kro[d0]), b1 = *(const LAS bf16x8*)(kb_ + kro[d0] + 32 * 256);
            p0 = __builtin_amdgcn_mfma_f32_32x32x16_bf16(b0, qr[d0], d0 == 0 ? zero16 : p0, 0, 0, 0); p1 = __builtin_amdgcn_mfma_f32_32x32x16_bf16(b1, qr[d0], d0 == 0 ? zero16 : p1, 0, 0, 0); }
        const float m_row = -nm; const float mnew = fmaxf(m_row, rowmax32(p0, p1)); const float al = __builtin_amdgcn_exp2f(m_row - mnew);
        if (hi == 0) al_l[r32] = al; asm volatile("s_waitcnt lgkmcnt(0)" ::: "memory");
#pragma unroll
        for (int d = 0; d < 2; ++d)
#pragma unroll
            for (int r = 0; r < 16; ++r) o[d][r] *= al_l[crow(r, hi)];
        lacc *= al;
#pragma unroll
        for (int r = 0; r < 16; ++r) { p0[r] -= mnew; p1[r] -= mnew; }
        nm = -mnew;
    };
    auto xseg = [&](const f32x16& INITV) __attribute__((always_inline)) {

#define PINP() asm volatile("" : "+v"(p0), "+v"(p1) :: "memory")
#define PINO() asm volatile("" : "+v"(o[0]), "+v"(o[1]) :: "memory")
#define VRD2(d0, k0) do { const LAS char* vb_ = lds + LDS_VR + vs * SHM_V + vro; _Pragma("unroll") for (int ks = (k0); ks < (k0) + 2; ++ks) { vl[d0][ks] = vtr(vb_ + att_v_rd_off(d0, ks, 0)); vh[d0][ks] = vtr(vb_ + att_v_rd_off(d0, ks, 1)); } } while (0)
#define KRD1(d0) do { const LAS char* kb_ = lds + LDS_KR + ks_ld * SHM_K; kf[d0][0] = *(const LAS bf16x8*)(kb_ + kro[d0]); kf[d0][1] = *(const LAS bf16x8*)(kb_ + kro[d0] + 32 * 256); } while (0)
#define VRD1(d0, ks) do { const LAS char* vb_ = lds + LDS_VR + vs * SHM_V + vro; vl[d0][ks] = vtr(vb_ + att_v_rd_off(d0, ks, 0)); vh[d0][ks] = vtr(vb_ + att_v_rd_off(d0, ks, 1)); } while (0)
#define QK1(d0, half, INIT) do { if (half == 0) p0 = __builtin_amdgcn_mfma_f32_32x32x16_bf16(kf[d0][0], qr[d0], (d0) == 0 ? (INIT) : p0, 0, 0, 0); else p1 = __builtin_amdgcn_mfma_f32_32x32x16_bf16(kf[d0][1], qr[d0], (d0) == 0 ? (INIT) : p1, 0, 0, 0); } while (0)
        QK1(0, 0, INITV); PINP(); VRD1(0, 0); PINP(); QK1(0, 1, INITV); PINP(); VRD1(0, 1); PINP();
        QK1(1, 0, INITV); PINP(); VRD1(0, 2); PINP(); QK1(1, 1, INITV); PINP(); VRD1(0, 3); PINP();
        QK1(2, 0, INITV); PINP(); VRD1(1, 0); PINP(); QK1(2, 1, INITV); PINP(); VRD1(1, 1); PINP();
        QK1(3, 0, INITV); PINP(); VRD1(1, 2); PINP(); QK1(3, 1, INITV); PINP(); VRD1(1, 3); PINP();
#define QKH(d0, half) do { if ((half) == 0) p0 = __builtin_amdgcn_mfma_f32_32x32x16_bf16(kf[d0][0], qr[d0], p0, 0, 0, 0); else p1 = __builtin_amdgcn_mfma_f32_32x32x16_bf16(kf[d0][1], qr[d0], p1, 0, 0, 0); } while (0)
        QKH(4, 0); QKH(4, 1); PINP(); KRD1(0); PINP(); QKH(5, 0); PINP(); KRD1(1); PINP(); QKH(5, 1); PINP(); KRD1(2); PINP();
        o[0] = __builtin_amdgcn_mfma_f32_32x32x16_bf16(pa0, VFR(0, 0), o[0], 0, 0, 0); PINO(); KRD1(3); PINO();
        o[0] = __builtin_amdgcn_mfma_f32_32x32x16_bf16(pa1, VFR(0, 1), o[0], 0, 0, 0); PINO(); KRD1(4); PINO();
        o[0] = __builtin_amdgcn_mfma_f32_32x32x16_bf16(pa2, VFR(0, 2), o[0], 0, 0, 0); PINO(); KRD1(5); PINO();
        ks_cur = NEXT5(ks_cur); ks_ld = NEXT5(ks_ld); ks_dma = NEXT5(ks_dma); vs = NEXT5(vs); vs_dma = NEXT5(vs_dma); ++j;
        kp += KVBLK * DQK * 2; vp += KVBLK * DV * 2; kd = (unsigned)(LDS_KR + ks_dma * SHM_K) + (unsigned)wid * 1024u; vd = (unsigned)(LDS_VR + vs_dma * SHM_V) + (unsigned)wid * 1024u;
        asm volatile("" : "+s"(ks_cur), "+s"(ks_ld), "+s"(vs), "+s"(kd), "+s"(vd), "+s"(j), "+s"(kp), "+s"(vp));
        o[0] = __builtin_amdgcn_mfma_f32_32x32x16_bf16(pa3, VFR(0, 3), o[0], 0, 0, 0); PINO();
        o[1] = __builtin_amdgcn_mfma_f32_32x32x16_bf16(pa0, VFR(1, 0), o[1], 0, 0, 0); PINO();
        o[1] = __builtin_amdgcn_mfma_f32_32x32x16_bf16(pa1, VFR(1, 1), o[1], 0, 0, 0); PINO();
        o[1] = __builtin_amdgcn_mfma_f32_32x32x16_bf16(pa2, VFR(1, 2), o[1], 0, 0, 0);
        o[1] = __builtin_amdgcn_mfma_f32_32x32x16_bf16(pa3, VFR(1, 3), o[1], 0, 0, 0);
#undef QKH
#undef PINP
#undef PINO
#undef VRD2
#undef KRD1
        SBAR();
        __builtin_amdgcn_s_waitcnt(0xC07F);
        asm volatile("s_waitcnt vmcnt(3)" ::: "memory");
        SBAR(); __builtin_amdgcn_s_barrier(); SBAR();
    };
    bool trig = false;
    if (!slow) {
#pragma unroll 1
        do {
            SBAR();
            float ps;
            expP0(p0); ps = expP1sum(p0, p1);
            if (__builtin_expect(__any(!(ps < ATT_OVF)), 0)) { trig = true; break; }
            lacc += ps; cvtP(p0, p1, pa0, pa1, pa2, pa3);
            SBAR(); DMA_NEXT(); SBAR(); __builtin_amdgcn_s_barrier(); SBAR();
            xseg(zero16);
        } while (j < NT);
        if (trig) reref();
    }
    if (j < NT) {
#pragma unroll 1
        do {
            SBAR();
            float ps;
            expP0(p0); ps = expP1sum(p0, p1);
            if (__builtin_expect(__any(!(ps < ATT_OVF)), 0)) { reref(); expP0(p0); ps = expP1sum(p0, p1); }
            lacc += ps; cvtP(p0, p1, pa0, pa1, pa2, pa3);
            f32x16 negm;
#pragma unroll
            for (int r = 0; r < 16; ++r) { float t_; asm("v_mov_b32 %0, %1" : "=v"(t_) : "v"(nm)); negm[r] = t_; }
            SBAR(); DMA_NEXT(); SBAR(); __builtin_amdgcn_s_barrier(); SBAR();
            xseg(negm);
        } while (j < NT);
    }
#undef DMA_NEXT
    asm volatile("s_waitcnt vmcnt(0)" ::: "memory");
    if (!g1) __builtin_amdgcn_s_barrier();
    __builtin_amdgcn_s_barrier();
    float l_reg; { auto rr = __builtin_amdgcn_permlane32_swap(__float_as_uint(lacc), __float_as_uint(lacc), false, false); l_reg = __uint_as_float(rr[0]) + __uint_as_float(rr[1]); }
    if (hi == 0) li_l[r32] = l_reg; asm volatile("s_waitcnt lgkmcnt(0)" ::: "memory");
    float rli[16];
#pragma unroll
    for (int r = 0; r < 16; ++r) rli[r] = __builtin_amdgcn_rcpf(li_l[crow(r, hi)]);
    LAS bf16* stg = (LAS bf16*)(lds + wid * 4096);
#pragma unroll
    for (int r = 0; r < 16; ++r) { const int orow = crow(r, hi);
#pragma unroll
        for (int d0 = 0; d0 < 2; ++d0) stg[orow * 64 + d0 * 32 + r32] = (bf16)(cvt_pk_bf16(o[d0][r] * rli[r], 0.f) & 0xffffu); }
    asm volatile("s_waitcnt lgkmcnt(0)" ::: "memory");
    bf16* Ow = Ob + (size_t)(wid * 32) * DM;
#pragma unroll
    for (int i = 0; i < 4; ++i) { const int row = i * 8 + (lane >> 3), ch = lane & 7; const v4u v = *(const LAS v4u*)(stg + row * 64 + ch * 8); *(v4u*)(Ow + (size_t)row * DM + ch * 8) = v; }
    asm volatile("s_waitcnt lgkmcnt(0)" ::: "memory"); __builtin_amdgcn_s_barrier();
#undef DMA_K
#undef DMA_V
#undef KLOAD
#undef VLOAD
#undef QKF
#undef QKSTEP
#undef VFR
#undef NEXT5
#undef NEXT3
}
}

namespace fft {
typedef short v4i16_t __attribute__((ext_vector_type(4)));
__device__ __forceinline__ s16x4 vtr(const LAS char* p) { return __builtin_bit_cast(s16x4, __builtin_amdgcn_ds_read_tr16_b64_v4i16((LAS v4i16_t*)p)); }
__device__ __forceinline__ int b_st(int k, int c) { const int kk = (k & ~0xC) | ((k & 4) << 1) | ((k & 8) >> 1); return ((kk >> 3) * 8 + (c >> 5)) * 512 + ((kk & 7) * 32 + (c & 31)) * 2; }
template <int PASS>
__device__ __forceinline__ void fft_unit(int b, int x, const bf16* __restrict__ Zb, bf16* __restrict__ U, bf16* __restrict__ Ob, const bf16* __restrict__ Amat, const float* __restrict__ TW, LAS char* lds, const int tid) {
    const int wid = tid >> 6, lane = tid & 63, r32 = lane & 31, hi = lane >> 5;
    {
        const unsigned lrow = (unsigned)tid >> 5, c = ((unsigned)tid & 31u) * 8u;
        LAS char* ldst = lds + b_st((int)lrow, (int)c);
        const char* ub; unsigned voff;
        if (PASS == 1) { ub = (const char*)(Zb + ((size_t)b * SEQ + x) * ZLD + ZC_FR); voff = (lrow * 128u * ZLD + c) * 2u; }
        else { ub = (const char*)(U + ((size_t)b * 128 + x) * 65536); voff = (lrow * 256u + c) * 2u; }
#pragma unroll
        for (int jb = 0; jb < 2; ++jb) {
            v4u tmp[8];
#pragma unroll
            for (int j = 0; j < 8; ++j) { const int J = jb * 8 + j; const size_t uo = (PASS == 1) ? ((size_t)(J & 7) * 16 * 128 * ZLD + (size_t)(J >> 3) * 256) * 2 : (size_t)J * 8192;
                tmp[j] = *(const v4u*)(ub + uo + voff); }
#pragma unroll
            for (int j = 0; j < 8; ++j) *(LAS v4u*)(ldst + (jb * 8 + j) * 8192) = tmp[j];
        }
    }
    constexpr int NT = 2, NHALF = (PASS == 1) ? 4 : 2;
    const int mrow = (PASS == 1) ? ((r32 < 16) ? (16 * wid + r32) : (128 + 16 * wid + r32 - 16)) : (32 * (wid >> 1) + r32);
    bf16x8 af[16];
#pragma unroll
    for (int ks = 0; ks < 16; ++ks) af[ks] = *reinterpret_cast<const bf16x8*>(Amat + (size_t)mrow * 256 + 16 * ks + 8 * hi);
    __syncthreads();
#pragma unroll 1
    for (int nh = 0; nh < NHALF; ++nh) {
        const int nt0 = (PASS == 1) ? 2 * nh : 4 * (wid & 1) + 2 * nh;
        f32x16 acc[NT];
#pragma unroll
        for (int d = 0; d < NT; ++d) acc[d] = f32x16{};
        const LAS char* vb = lds + att::v_rd_base(lane) + nt0 * 512;
#pragma unroll
        for (int ks = 0; ks < 16; ++ks) {
#pragma unroll
            for (int d = 0; d < NT; ++d) { const s16x4 l = vtr(vb + ks * 8192 + d * 512), h = vtr(vb + ks * 8192 + 4096 + d * 512);
                acc[d] = __builtin_amdgcn_mfma_f32_32x32x16_bf16(af[ks], (bf16x8){l[0], l[1], l[2], l[3], h[0], h[1], h[2], h[3]}, acc[d], 0, 0, 0); }
            if (ks & 1) __builtin_amdgcn_sched_barrier(0);
        }
        if (PASS == 1) {
#pragma unroll
            for (int r = 0; r < 8; ++r) { const int k1 = 16 * wid + att::crow(r, hi); const f32x2 t = *(const f32x2*)(TW + ((size_t)k1 * 128 + x) * 2);
                bf16* ur = U + ((((size_t)b * 128 + k1) * 2 + 0) * 128 + x) * 256 + nt0 * 32; bf16* ui = ur + 128 * 256;
#pragma unroll
                for (int d = 0; d < NT; ++d) { const float re = acc[d][r], im = acc[d][r + 8];
                    const unsigned pk = cvt_pk_bf16(re * t.x + im * t.y, im * t.x - re * t.y);
                    ur[d * 32 + r32] = (bf16)(pk & 0xffffu); ui[d * 32 + r32] = (bf16)(pk >> 16); } }
        } else {
#pragma unroll
            for (int r = 0; r < 16; ++r) { const int k2 = 32 * (wid >> 1) + att::crow(r, hi); bf16* orow = Ob + ((size_t)b * SEQ + x + 128 * k2) * DM + 768 + nt0 * 32;
#pragma unroll
                for (int d = 0; d < NT; ++d) orow[d * 32 + r32] = (bf16)(cvt_pk_bf16(acc[d][r], 0.f) & 0xffffu); }
        }
    }
    __syncthreads();
}
}

#define XB_TMO      128
#define XB_XCNT(j)  (256  + 64 * (j))
#define XB_XSUB(j)  (1280 + 64 * (j))
#define XB_XGEN(j)  (2304 + 64 * (j))
#define XB_TOP      3328
#define XB_TOPGEN   3392
#define XCD_BAR_WORDS 3456
#define XB_SPIN_CAP (1u << 20)
__device__ __forceinline__ unsigned xb_ld(unsigned* p)              { return __hip_atomic_load(p, __ATOMIC_RELAXED, __HIP_MEMORY_SCOPE_AGENT); }
__device__ __forceinline__ unsigned xb_add(unsigned* p, unsigned v) { return __hip_atomic_fetch_add(p, v, __ATOMIC_RELAXED, __HIP_MEMORY_SCOPE_AGENT); }
__device__ __forceinline__ unsigned xb_xcc_id() { return (unsigned)__builtin_amdgcn_s_getreg((3 << 11) | 20) & 0xFu; }
#define XB_SPIN(cond, bar) do { unsigned _sp = 0; while (cond) { __builtin_amdgcn_s_sleep(1); \
    if ((++_sp & 255u) == 0u) { if (xb_ld(&(bar)[XB_TMO])) break; if (_sp > XB_SPIN_CAP) { atomicAdd(&(bar)[XB_TMO], 1u); break; } } } } while (0)
struct XcdBarrier { unsigned* bar; unsigned x; volatile LAS unsigned* st; };
__device__ __forceinline__ XcdBarrier xcd_barrier_post(unsigned* bar, volatile LAS unsigned* st) {
    XcdBarrier b; b.bar = bar; b.x = xb_xcc_id(); b.st = st;
    if (threadIdx.x == 0) (void)xb_add(&bar[XB_XCNT(b.x)], 1u);
    return b;
}
__device__ __forceinline__ void xcd_barrier_complete(unsigned* bar, unsigned x, unsigned& nloc, unsigned& nx) {
    const unsigned G = gridDim.x * gridDim.y * gridDim.z;
    unsigned sum, cnt, mine, sp = 0u;
    for (;;) {
        sum = 0u; cnt = 0u; mine = 0u;
#pragma unroll
        for (unsigned j = 0; j < 16; ++j) { const unsigned c = xb_ld(&bar[XB_XCNT(j)]); sum += c; cnt += (c > 0u) ? 1u : 0u; mine = (j == x) ? c : mine; }
        if (sum == G) break;
        __builtin_amdgcn_s_sleep(1);
        if ((++sp & 255u) == 0u) { if (xb_ld(&bar[XB_TMO])) break; if (sp > XB_SPIN_CAP) { atomicAdd(&bar[XB_TMO], 1u); break; } }
    }
    nloc = mine > 0u ? mine : 1u; nx = cnt > 0u ? cnt : 1u;
}
__device__ __forceinline__ void xcd_barrier(const XcdBarrier& b) {
    asm volatile("s_waitcnt vmcnt(0)" ::: "memory");
    __syncthreads();
    if (threadIdx.x == 0) {
        unsigned* bar = b.bar;
        __builtin_amdgcn_s_waitcnt(0);
        unsigned nloc = b.st[0], nx = b.st[1];
        if (nloc == 0u) { xcd_barrier_complete(bar, b.x, nloc, nx); b.st[0] = nloc; b.st[1] = nx; }
        const unsigned old = xb_add(&bar[XB_XSUB(b.x)], 1u);
        const unsigned gen = old / nloc;
        if (old + 1u == (gen + 1u) * nloc) {
            __builtin_amdgcn_fence(__ATOMIC_RELEASE, "agent");
            asm volatile("s_waitcnt vmcnt(0)" ::: "memory");
            const unsigned og = xb_add(&bar[XB_TOP], 1u);
            const unsigned tg = og / nx;
            if (og + 1u == (tg + 1u) * nx) xb_add(&bar[XB_TOPGEN], 1u);
            else XB_SPIN(xb_ld(&bar[XB_TOPGEN]) == tg, bar);
            __builtin_amdgcn_fence(__ATOMIC_ACQUIRE, "agent");
            xb_add(&bar[XB_XGEN(b.x)], 1u);
            asm volatile("s_waitcnt vmcnt(0)" ::: "memory");
        } else {
            XB_SPIN(xb_ld(&bar[XB_XGEN(b.x)]) == gen, bar);
            __builtin_amdgcn_fence(__ATOMIC_ACQUIRE, "agent");
            asm volatile("s_waitcnt vmcnt(0)" ::: "memory");
        }
    }
    __syncthreads();
}

struct Args {
    const float *x, *ln_in_g, *ln_in_b, *w_in, *g_q, *g_kv, *w_uq, *w_ukv, *w_conv, *w_out, *ln1_g, *ln1_b, *w_group, *b_group, *w_router, *b_router, *w_gate, *w_up, *w_down, *ln2_g, *ln2_b;
    float* out; unsigned char* ws; int ph_lo, ph_hi, sub, pad;
};
constexpr int PH_PER_LAYER = 11, N_PHASES = 1 + DEPTH * PH_PER_LAYER;

template <class F4> __device__ __forceinline__ void tr_item(F4 f4, bf16* WT, int ldt, int k0, int n0, LAS float* scr, int lane) {
    const int krow = lane >> 3, nq = lane & 7; f32x4 t[8];
#pragma unroll
    for (int i = 0; i < 8; ++i) t[i] = f4(k0 + 8 * i + krow, n0 + 4 * nq);
#pragma unroll
    for (int i = 0; i < 8; ++i) *(LAS f32x4*)(scr + (8 * i + krow) * 36 + 4 * nq) = t[i];
    LDS_WAIT(); asm volatile("" ::: "memory");
    const int c = lane & 7;
#pragma unroll
    for (int j = 0; j < 4; ++j) { const int n = (lane >> 3) + 8 * j; const LAS float* sp = scr + (8 * c) * 36 + n;
        v4u o; o.x = cvt_pk_bf16(sp[0 * 36], sp[1 * 36]); o.y = cvt_pk_bf16(sp[2 * 36], sp[3 * 36]); o.z = cvt_pk_bf16(sp[4 * 36], sp[5 * 36]); o.w = cvt_pk_bf16(sp[6 * 36], sp[7 * 36]);
        *(v4u*)(WT + (size_t)(n0 + n) * ldt + k0 + 8 * c) = o; }
    LDS_WAIT(); asm volatile("" ::: "memory");
}
__device__ __forceinline__ void ln_finish(f32x4 (&v)[4], const float* g, const float* bta, int lane, bf16* obf, float* of32) {
    float s = 0.f;
#pragma unroll
    for (int j = 0; j < 4; ++j) s += (v[j][0] + v[j][1]) + (v[j][2] + v[j][3]);
    const float mean = wave_sum(s) * (1.f / DM); float s2 = 0.f;
#pragma unroll
    for (int j = 0; j < 4; ++j) { v[j] = v[j] - mean; s2 += (v[j][0] * v[j][0] + v[j][1] * v[j][1]) + (v[j][2] * v[j][2] + v[j][3] * v[j][3]); }
    const float rstd = 1.f / sqrtf(wave_sum(s2) * (1.f / DM) + LN_EPS);
#pragma unroll
    for (int j = 0; j < 4; ++j) { const f32x4 gg = *(const f32x4*)(g + 4 * lane + 256 * j), bb = *(const f32x4*)(bta + 4 * lane + 256 * j);
        const f32x4 r = v[j] * rstd * gg + bb;
        if (obf) { v2u w; w.x = cvt_pk_bf16(r[0], r[1]); w.y = cvt_pk_bf16(r[2], r[3]); *(v2u*)(obf + 4 * lane + 256 * j) = w; }
        else *(f32x4*)(of32 + 4 * lane + 256 * j) = r; }
}


__device__ __forceinline__ void unpack8(const v4u w, float (&f)[8]) { f[0] = bf_lo(w.x); f[1] = bf_hi(w.x); f[2] = bf_lo(w.y); f[3] = bf_hi(w.y); f[4] = bf_lo(w.z); f[5] = bf_hi(w.z); f[6] = bf_lo(w.w); f[7] = bf_hi(w.w); }
__device__ __forceinline__ void ln16(float (&v)[16], const float* g, const float* bta, int lane, bf16* obf, float* of32) {
    float s = 0.f;
#pragma unroll
    for (int i = 0; i < 16; ++i) s += v[i];
    const float mean = wave_sum(s) * (1.f / DM); float s2 = 0.f;
#pragma unroll
    for (int i = 0; i < 16; ++i) { v[i] -= mean; s2 += v[i] * v[i]; }
    const float rstd = 1.f / sqrtf(wave_sum(s2) * (1.f / DM) + LN_EPS);
#pragma unroll
    for (int j = 0; j < 2; ++j) { const int e0 = 8 * lane + 512 * j; const f32x4 g0 = *(const f32x4*)(g + e0), g1 = *(const f32x4*)(g + e0 + 4), b0 = *(const f32x4*)(bta + e0), b1 = *(const f32x4*)(bta + e0 + 4);
        f32x4 r0, r1;
#pragma unroll
        for (int i = 0; i < 4; ++i) { r0[i] = v[8 * j + i] * rstd * g0[i] + b0[i]; r1[i] = v[8 * j + 4 + i] * rstd * g1[i] + b1[i]; }
        if (obf) { v4u w; w.x = cvt_pk_bf16(r0[0], r0[1]); w.y = cvt_pk_bf16(r0[2], r0[3]); w.z = cvt_pk_bf16(r1[0], r1[1]); w.w = cvt_pk_bf16(r1[2], r1[3]); *(v4u*)(obf + e0) = w; }
        else { *(f32x4*)(of32 + e0) = r0; *(f32x4*)(of32 + e0 + 4) = r1; } }
}
#if PROBE_CHECK
__device__ __forceinline__ float bf2f(bf16 v) { return __uint_as_float((unsigned)v << 16); }
__device__ __forceinline__ void diag_max(gu32* w, float v) { atomicMax((unsigned*)w, __float_as_uint(v < 0.f ? 0.f : v)); }
__device__ __forceinline__ void block_sum2(float& a, float& b, LAS float* red, int tid) {
    a = wave_sum(a); b = wave_sum(b); __syncthreads();
    if ((tid & 63) == 0) { red[tid >> 6] = a; red[8 + (tid >> 6)] = b; } __syncthreads();
    float sa = 0.f, sb = 0.f; for (int i = 0; i < 8; ++i) { sa += red[i]; sb += red[8 + i]; } a = sa; b = sb; __syncthreads();
}
__device__ __forceinline__ void probe_rope(int s, int j, float& cs, float& sn) {
    const int jq = j & 3; const double b4 = jq == 0 ? 1.0 : (jq == 1 ? 0.5623413251903491 : (jq == 2 ? 0.31622776601683794 : 0.1778279410038923)); const int jd = j >> 2; const double d10 = jd == 0 ? 1.0 : (jd == 1 ? 0.1 : (jd == 2 ? 0.01 : 0.001));
    const float ang = (float)s * (float)(b4 * d10); const double rev = (double)ang * 0.15915494309189535; const float fr_ = (float)(rev - floor(rev)); cs = __builtin_amdgcn_cosf(fr_); sn = __builtin_amdgcn_sinf(fr_);
}
__device__ __forceinline__ void probe_qkv(const __attribute__((address_space(4))) Args* AP, int l, int t, const bf16* Zb, const bf16* Qb, const bf16* Kb, const bf16* Vb, gu32* ctl, LAS float* sh, int tid) {
    const int b = t / SEQ, s = t - b * SEQ;
    for (int i = tid; i < 672; i += 512) sh[i] = bf2f(Zb[(size_t)t * ZLD + i]);
    __syncthreads();
    float sq = 0.f, sk = 0.f; for (int i = tid; i < 384; i += 512) sq += sh[i] * sh[i]; for (int i = tid; i < 256; i += 512) sk += sh[384 + i] * sh[384 + i];
    block_sum2(sq, sk, sh + 8000, tid);
    const float rq = 1.0f / sqrtf(sq / 384.f + RMS_EPS), rk = 1.0f / sqrtf(sk / 256.f + RMS_EPS);
    const float* wuq = AP->w_uq + (size_t)l * 384 * 768; const float* wukv = AP->w_ukv + (size_t)l * 256 * 1024; const float* gq = AP->g_q + l * 384; const float* gk = AP->g_kv + l * 256;
    for (int n = tid; n < 768; n += 512) { float a = 0.f; for (int k = 0; k < 384; ++k) a += sh[k] * gq[k] * wuq[(size_t)k * 768 + n]; sh[1024 + n] = a * rq; }
    for (int n = tid; n < 1024; n += 512) { float a = 0.f; for (int k = 0; k < 256; ++k) a += sh[384 + k] * gk[k] * wukv[(size_t)k * 1024 + n]; sh[2048 + n] = a * rk; }
    __syncthreads();
    float nq = 0.f, dq = 0.f, nk = 0.f, dk = 0.f, nv = 0.f, dv = 0.f;
    for (int i = tid; i < 768; i += 512) { const int h = i / 96, d = i - 96 * h; float ref;
        ref = sh[1024 + i];
        ref *= QSCALE; const float mine = bf2f(Qb[((size_t)(b * NH + h) * SEQ + s) * DQK + d]); nq += (ref - mine) * (ref - mine); dq += ref * ref; }
    for (int i = tid; i < 768; i += 512) { const int h = i / 96, d = i - 96 * h; float ref;
        if (d < 64) ref = sh[2048 + h * 128 + d];
        else { const int j = (d - 64) & 15; float cs, sn; probe_rope(s, j, cs, sn); const float t1 = sh[640 + j], t2 = sh[656 + j];
            ref = (d < 80) ? (t1 * cs - t2 * sn) : (t1 * sn + t2 * cs); }
        const float mine = bf2f(Kb[((size_t)(b * NH + h) * SEQ + s) * DQK + d]); nk += (ref - mine) * (ref - mine); dk += ref * ref; }
    for (int i = tid; i < 512; i += 512) { const int h = i >> 6, d = i & 63; const float ref = sh[2048 + h * 128 + 64 + d], mine = bf2f(Vb[((size_t)(b * NH + h) * SEQ + s) * DV + d]); nv += (ref - mine) * (ref - mine); dv += ref * ref; }
    block_sum2(nq, dq, sh + 8000, tid); block_sum2(nk, dk, sh + 8000, tid); block_sum2(nv, dv, sh + 8000, tid);
    if (tid == 0) { diag_max(ctl + CW_DIAG, sqrtf(nq / dq)); diag_max(ctl + CW_DIAG, sqrtf(nk / dk)); diag_max(ctl + CW_DIAG, sqrtf(nv / dv)); }
    __syncthreads();
}
__device__ __forceinline__ void probe_attn(int bh, int s, const bf16* Qb, const bf16* Kb, const bf16* Vb, const bf16* Ob, gu32* ctl, LAS float* sh, int tid) {
    const int b = bh >> 3, h = bh & 7;
    if (tid < 96) sh[tid] = bf2f(Qb[((size_t)bh * SEQ + s) * DQK + tid]);
    __syncthreads();
    if (tid < 16) { float cs, sn; probe_rope(s, tid, cs, sn); const float t1 = sh[64 + tid], t2 = sh[80 + tid]; sh[64 + tid] = t1 * cs - t2 * sn; sh[80 + tid] = t1 * sn + t2 * cs; }
    __syncthreads();
    float mx = -1e30f;
    for (int j = tid; j < SEQ; j += 512) { const bf16* kr = Kb + ((size_t)bh * SEQ + j) * DQK; float sc = 0.f;
#pragma unroll 8
        for (int d = 0; d < 96; ++d) sc += sh[d] * bf2f(kr[d]);
        sh[1024 + j] = sc; mx = fmaxf(mx, sc); }
    for (int o = 1; o < 64; o <<= 1) mx = fmaxf(mx, __shfl_xor(mx, o));
    if ((tid & 63) == 0) sh[256 + (tid >> 6)] = mx; __syncthreads();
    mx = sh[256]; for (int i = 1; i < 8; ++i) mx = fmaxf(mx, sh[256 + i]);
    const int d = tid & 63, sub = tid >> 6; float ls = 0.f, a = 0.f;
    for (int j = sub; j < SEQ; j += 8) { const float pj = exp2f(sh[1024 + j] - mx); ls += pj; a += pj * bf2f(Vb[((size_t)bh * SEQ + j) * DV + d]); }
    sh[300 + tid] = a; if (d == 0) sh[900 + sub] = ls; __syncthreads();
    float nn = 0.f, dd = 0.f;
    if (tid < 64) { float av = 0.f, lv = 0.f; for (int i = 0; i < 8; ++i) { av += sh[300 + 64 * i + tid]; lv += sh[900 + i]; }
        const float ref = av / lv, mine = bf2f(Ob[((size_t)b * SEQ + s) * DM + h * DV + tid]); nn = (ref - mine) * (ref - mine); dd = ref * ref; }
    block_sum2(nn, dd, sh + 20000, tid);
    if (tid == 0) diag_max(ctl + CW_DIAG, sqrtf(nn / dd));
    __syncthreads();
}
__device__ __forceinline__ void probe_moe(const __attribute__((address_space(4))) Args* AP, int l, int t, const bf16* Hb, const v4u* TOK, const bf16* PARTS, gu32* ctl, LAS float* sh, int tid) {
    for (int i = tid; i < 1024; i += 512) sh[i] = bf2f(Hb[(size_t)t * DM + i]);
    __syncthreads();
    if (tid < 36) { float a = 0.f; if (tid < 4) { const float* w = AP->w_group + (size_t)l * DM * 4; for (int k = 0; k < DM; ++k) a += sh[k] * w[k * 4 + tid]; a += AP->b_group[l * 4 + tid]; }
        else { const float* w = AP->w_router + (size_t)l * DM * 32; for (int k = 0; k < DM; ++k) a += sh[k] * w[k * 32 + tid - 4]; a += AP->b_router[l * 32 + tid - 4]; }
        sh[1100 + tid] = a; }
    __syncthreads();
    if (tid == 0) { int gi = 0; for (int i = 1; i < 4; ++i) if (sh[1100 + i] > sh[1100 + gi]) gi = i; float gs = 0.f; for (int i = 0; i < 4; ++i) gs += expf(sh[1100 + i] - sh[1100 + gi]); const float pg = 1.f / gs;
        const LAS float* el = sh + 1104 + 8 * gi; int i1 = 0; for (int i = 1; i < 8; ++i) if (el[i] > el[i1]) i1 = i; int i2 = (i1 == 0) ? 1 : 0; for (int i = 0; i < 8; ++i) if (i != i1 && el[i] > el[i2]) i2 = i;
        const float p1 = 1.f / (1.f + expf(el[i2] - el[i1])); const v4u ti = TOK[t]; const int e1 = ti.x & 255, e2 = ti.y & 255; float w1 = __uint_as_float(ti.z), w2 = __uint_as_float(ti.w);
        const bool same = (e1 == 8 * gi + i1) && (e2 == 8 * gi + i2);
        float werr = 0.f; if (same) { werr = fmaxf(fabsf(w1 - p1 * pg) / (p1 * pg), fabsf(w2 - (1.f - p1) * pg) / ((1.f - p1) * pg)); } else atomicAdd((unsigned*)(ctl + CW_DIAG2), 1u);
        diag_max(ctl + CW_DIAG, werr); sh[1200] = (float)e1; sh[1201] = (float)e2; sh[1202] = w1; sh[1203] = w2; }
    __syncthreads();
    for (int kx = 0; kx < 2; ++kx) { const int e = (int)sh[1200 + kx]; const float w = sh[1202 + kx]; const size_t le = (size_t)l * NEXP + e;
        const float* wg = ((tid < 256) ? AP->w_gate : AP->w_up) + le * DM * DEXP; const int f = tid & 255; float a = 0.f; for (int k = 0; k < DM; ++k) a += sh[k] * wg[(size_t)k * DEXP + f];
        sh[2048 + tid] = a; __syncthreads();
        if (tid < 256) { const float g = sh[2048 + tid], u = sh[2048 + 256 + tid]; sh[3072 + tid] = g / (1.f + expf(-g)) * u * w; } __syncthreads();
        const float* wd = AP->w_down + le * DEXP * DM; float nn = 0.f, dd = 0.f;
        for (int d = tid; d < DM; d += 512) { float a2 = 0.f; for (int ff = 0; ff < DEXP; ++ff) a2 += sh[3072 + ff] * wd[(size_t)ff * DM + d]; const float mine = bf2f(PARTS[(size_t)(2 * t + kx) * DM + d]); nn += (a2 - mine) * (a2 - mine); dd += a2 * a2; }
        block_sum2(nn, dd, sh + 8000, tid);
        if (tid == 0) diag_max(ctl + CW_DIAG, sqrtf(nn / dd));
        __syncthreads(); }
}
#endif

__global__ void __launch_bounds__(NWAVES * 64, 2) fwd(Args A) {
    extern __shared__ __attribute__((aligned(16))) unsigned char lds_raw[];
    LAS unsigned char* lds = (LAS unsigned char*)lds_raw;
    volatile LAS unsigned* MISC = (volatile LAS unsigned*)(lds + MISC_OFF);
    LAS int* seg = (LAS int*)(lds + SEG_OFF);
    const int G = gridDim.x; const int vcu = (G % 8 == 0) ? ((int)blockIdx.x % 8) * (G / 8) + (int)blockIdx.x / 8 : (int)blockIdx.x;
    for (int u = threadIdx.x; u < (LDS_BYTES - LDSCTL_OFF) / 4; u += NWAVES * 64) ((LAS unsigned*)(lds + LDSCTL_OFF))[u] = 0u;
    __syncthreads();
#if MK_PER_PHASE
#define GRID_BAR() do { } while (0)
#else
    XcdBarrier bar = xcd_barrier_post((unsigned*)(A.ws + WS_CTL) + CW_BAR, MISC + 8);
#define GRID_BAR() xcd_barrier(bar)
#endif
    const int lo = A.ph_lo, hi = A.ph_hi;
#ifndef PH_MASK
#define PH_MASK 0xFFF
#endif
#define PHM(j) (((PH_MASK) >> (j)) & 1)
#undef SUBM
#define SUBM (AP->sub)
#define IN(k) (lo <= (k) && (k) < hi)
#define SEAM(k) do { if (IN(k) && IN((k) + 1)) GRID_BAR(); } while (0)
#define PH_IDS() int tid = threadIdx.x; asm volatile("" : "+v"(tid)); const int lane = tid & 63, wave = __builtin_amdgcn_readfirstlane(tid >> 6); const int gw = vcu * NWAVES + wave, NGW = G * NWAVES; \
    const __attribute__((address_space(4))) Args* AP = (const __attribute__((address_space(4))) Args*)__builtin_amdgcn_kernarg_segment_ptr(); asm volatile("" : "+s"(AP)); \
    unsigned char* ws = AP->ws; unsigned char* dout = (unsigned char*)AP->out; (void)lane; (void)gw; (void)NGW; (void)dout; \
    gu32* ctl = (gu32*)(ws + WS_CTL); (void)ctl; \
    bf16* Hb = (bf16*)(ws + WS_H); bf16* Zb = (bf16*)(ws + WS_Z); bf16* Vb = (bf16*)(ws + WS_V); bf16* Ob = (bf16*)(ws + WS_O); \
    bf16* Qb = (bf16*)(dout + DO_Q); bf16* Kb = (bf16*)(dout + DO_K); bf16* Ub = (bf16*)(dout + DO_U); \
    bf16* Y1 = (bf16*)dout; bf16* PARTS = (bf16*)dout; bf16* XG = (bf16*)(ws + WS_Z); bf16* HID = (bf16*)(ws + WS_O); \
    float* SSQ = (float*)(ws + WS_SSQ); float* LG = (float*)(ws + WS_LG); v4u* TOK = (v4u*)(ws + WS_TOK); \
    int* ROWTOK = (int*)(ws + WS_ROWTOK); float* ROWW = (float*)(ws + WS_ROWTOK + 512 * 1024); \
    float* RCOS = (float*)(ws + WS_ROPE); float* RSIN = RCOS + SEQ * 16; \
    bf16* FA1 = (bf16*)(ws + WS_FA1); bf16* FA2 = FA1 + 256 * 256; float* TW = (float*)(ws + WS_FA1 + 256 * 1024); \
    (void)Hb; (void)Zb; (void)Vb; (void)Ob; (void)Qb; (void)Kb; (void)Ub; (void)Y1; (void)PARTS; (void)XG; (void)HID; (void)SSQ; (void)LG; (void)TOK; (void)ROWTOK; (void)ROWW; (void)RCOS; (void)RSIN; (void)FA1; (void)FA2; (void)TW;

    if (PHM(0) && IN(0)) { PH_IDS()
        LAS float* scr = (LAS float*)(lds + wave * 16384);
        int it = gw;
#define JOB_BEGIN(cnt) { const int cnt_ = (cnt); for (; it < cnt_; it += NGW) {
#define JOB_END } it -= cnt_; }
        JOB_BEGIN(DEPTH * 16 * 45) const int l = it / (16 * 45), r = it % (16 * 45), kb = r / 45, nb = r % 45; const int n0 = nb < 21 ? 32 * nb : 768 + 32 * (nb - 21), sc = nb < 21 ? 0 : -96;
            const float* W = AP->w_in + (size_t)l * DM * DIN; tr_item([&](int k, int n) { return *(const f32x4*)(W + (size_t)k * DIN + n + sc); }, (bf16*)(ws + WS_WIN) + (size_t)l * ZLD * DM, DM, 64 * kb, n0, scr, lane);  JOB_END
        JOB_BEGIN(DEPTH * 6 * 24) const int l = it / (6 * 24), r = it % (6 * 24), kb = r / 24, nb = r % 24; const float* W = AP->w_uq + (size_t)l * QLORA * 768; const float* gq = AP->g_q + l * QLORA;
            tr_item([&](int k, int n) { return *(const f32x4*)(W + (size_t)k * 768 + n) * gq[k]; }, (bf16*)(ws + WS_WUQ + l * MiB), QLORA, 64 * kb, 32 * nb, scr, lane);  JOB_END
        JOB_BEGIN(DEPTH * 4 * 32) const int l = it / (4 * 32), r = it % (4 * 32), kb = r / 32, nb = r % 32; const float* W = AP->w_ukv + (size_t)l * KVLORA * 1024; const float* gk = AP->g_kv + l * KVLORA;
            const int n0 = 32 * nb; const int src0 = n0 < 512 ? (n0 >> 6) * 128 + (n0 & 63) : ((n0 - 512) >> 6) * 128 + 64 + ((n0 - 512) & 63);
            tr_item([&](int k, int n) { return *(const f32x4*)(W + (size_t)k * 1024 + src0 + (n - n0)) * gk[k]; }, (bf16*)(ws + WS_WUKV + l * MiB), KVLORA, 64 * kb, n0, scr, lane);  JOB_END
        JOB_BEGIN(DEPTH * 16 * 32) const int l = it / (16 * 32), r = it % (16 * 32), kb = r / 32, nb = r % 32; const float* W = AP->w_out + (size_t)l * DM * DM;
            tr_item([&](int k, int n) { return *(const f32x4*)(W + (size_t)k * DM + n); }, (bf16*)(ws + WS_WOUT) + (size_t)l * DM * DM, DM, 64 * kb, 32 * nb, scr, lane);  JOB_END
        JOB_BEGIN(NEXP * 16 * 16) const int le = it / 256, r = it % 256, kb = r / 16, nb = r % 16; const int n0 = 32 * nb, pn = n0 >> 8, j0 = n0 & 255;
            const float* W = ((j0 < 128) ? AP->w_gate : AP->w_up) + (size_t)le * DM * DEXP; const int src0 = 128 * pn + (j0 & 127);
            tr_item([&](int k, int n) { return *(const f32x4*)(W + (size_t)k * DEXP + src0 + (n - n0)); }, (bf16*)(ws + WS_WGU) + (size_t)le * 512 * DM, DM, 64 * kb, n0, scr, lane);  JOB_END
        JOB_BEGIN(NEXP * 4 * 32) const int le = it / 128, r = it % 128, kb = r / 32, nb = r % 32; const float* W = AP->w_down + (size_t)le * DEXP * DM;
            tr_item([&](int k, int n) { return *(const f32x4*)(W + (size_t)k * DM + n); }, (bf16*)(ws + WS_WD) + (size_t)le * DM * DEXP, DEXP, 64 * kb, 32 * nb, scr, lane);  JOB_END
        JOB_BEGIN(DEPTH * 4 * 16 * 8) const int l = it / 512, r = it % 512, g4 = r / 128, kb = (r / 8) % 16, cb = r % 8; const int k = 64 * kb + lane;
            const float* wr = AP->w_in + (size_t)l * DM * DIN + (size_t)k * DIN + 1440 + 64 * g4; float fv[64];
#pragma unroll
            for (int c = 0; c < 64; c += 4) { const f32x4 t4 = *(const f32x4*)(wr + c); fv[c] = t4[0]; fv[c + 1] = t4[1]; fv[c + 2] = t4[2]; fv[c + 3] = t4[3]; }
            bf16* dst = (bf16*)(ws + WS_WIN) + (size_t)l * ZLD * DM;
            for (int cc = 0; cc < 8; ++cc) { const int cp = 8 * cb + cc; float ar = 0.f, ai = 0.f;
#pragma unroll
                for (int c = 0; c < 64; ++c) { const float fr_ = (float)((c * cp) & 63) * (1.0f / 64.0f); ar += fv[c] * __builtin_amdgcn_cosf(fr_); ai -= fv[c] * __builtin_amdgcn_sinf(fr_); }
                dst[(size_t)(ZC_FR + 64 * g4 + cp) * DM + k] = (bf16)(cvt_pk_bf16(ar * 0.125f, 0.f) & 0xffffu);
                dst[(size_t)(ZC_FR + 256 + 64 * g4 + cp) * DM + k] = (bf16)(cvt_pk_bf16(ai * 0.125f, 0.f) & 0xffffu); }  JOB_END
        JOB_BEGIN(DEPTH * 96 * 128) const int l = it / (96 * 128), r = it % (96 * 128), n = 672 + r / 128, kc = r % 128; *(v4u*)((bf16*)(ws + WS_WIN) + (size_t)l * ZLD * DM + (size_t)n * DM + 8 * kc) = (v4u){0u, 0u, 0u, 0u};  JOB_END
        JOB_BEGIN(DEPTH * 256 * 128) const int l = it / (256 * 128), r = it % (256 * 128), n = r / 128, kc = r % 128; float v[8];
#pragma unroll
            for (int i = 0; i < 8; ++i) { const int k = 8 * kc + i; v[i] = n < 4 ? AP->w_group[(size_t)l * DM * 4 + (size_t)k * 4 + n] : (n < 36 ? AP->w_router[(size_t)l * DM * 32 + (size_t)k * 32 + (n - 4)] : 0.f); }
            v4u o; o.x = cvt_pk_bf16(v[0], v[1]); o.y = cvt_pk_bf16(v[2], v[3]); o.z = cvt_pk_bf16(v[4], v[5]); o.w = cvt_pk_bf16(v[6], v[7]);
            *(v4u*)((bf16*)(ws + WS_WR) + (size_t)l * 256 * DM + (size_t)n * DM + 8 * kc) = o;  JOB_END
#undef JOB_BEGIN
#undef JOB_END
        const int gt = vcu * (NWAVES * 64) + tid, NGT = G * NWAVES * 64;
        for (int i = gt; i < SEQ * 16; i += NGT) { const int s = i >> 4, j = i & 15; const int jq = j & 3; const double b4 = jq == 0 ? 1.0 : (jq == 1 ? 0.5623413251903491 : (jq == 2 ? 0.31622776601683794 : 0.1778279410038923)); const int jd = j >> 2; const double d10 = jd == 0 ? 1.0 : (jd == 1 ? 0.1 : (jd == 2 ? 0.01 : 0.001)); const float invf = (float)(b4 * d10); const float ang = (float)s * invf;
            const double rev = (double)ang * 0.15915494309189535; const float fr_ = (float)(rev - floor(rev)); RCOS[i] = __builtin_amdgcn_cosf(fr_); RSIN[i] = __builtin_amdgcn_sinf(fr_); }
        for (int i = gt; i < 256 * 256; i += NGT) { const int m = i >> 8, k = i & 255, ro = m >> 7, k1 = m & 127, ri = k >> 7, s1 = k & 127; const float fr_ = (float)((k1 * s1) & 127) * (1.0f / 128.0f);
            const float c = __builtin_amdgcn_cosf(fr_) * 0.08838834764831845f, s = __builtin_amdgcn_sinf(fr_) * 0.08838834764831845f;
            const float v = (ro == ri) ? c : (ro == 0 ? s : -s); FA1[i] = (bf16)(cvt_pk_bf16(v, 0.f) & 0xffffu); }
        for (int i = gt; i < 128 * 256; i += NGT) { const int k2 = i >> 8, k = i & 255, ri = k >> 7, s2 = k & 127; const float fr_ = (float)((k2 * s2) & 127) * (1.0f / 128.0f);
            const float v = (ri == 0 ? __builtin_amdgcn_cosf(fr_) : __builtin_amdgcn_sinf(fr_)) * 0.08838834764831845f; FA2[i] = (bf16)(cvt_pk_bf16(v, 0.f) & 0xffffu); }
        for (int i = gt; i < 128 * 128; i += NGT) { const int k1 = i >> 7, s2 = i & 127; const float fr_ = (float)(k1 * s2) * (1.0f / 16384.0f); TW[2 * i] = __builtin_amdgcn_cosf(fr_); TW[2 * i + 1] = __builtin_amdgcn_sinf(fr_); }
        for (int m0 = 2 * gw; m0 < NTOK; m0 += 2 * NGW) { float va[16], vb[16];
#pragma unroll
            for (int j = 0; j < 2; ++j) { const float* xa = AP->x + (size_t)m0 * DM + 8 * lane + 512 * j; const f32x4 a0 = *(const f32x4*)xa, a1 = *(const f32x4*)(xa + 4), b0 = *(const f32x4*)(xa + DM), b1 = *(const f32x4*)(xa + DM + 4);
#pragma unroll
                for (int i = 0; i < 4; ++i) { va[8 * j + i] = a0[i]; va[8 * j + 4 + i] = a1[i]; vb[8 * j + i] = b0[i]; vb[8 * j + 4 + i] = b1[i]; } }
            ln16(va, AP->ln_in_g, AP->ln_in_b, lane, Hb + (size_t)m0 * DM, nullptr); ln16(vb, AP->ln_in_g, AP->ln_in_b, lane, Hb + (size_t)(m0 + 1) * DM, nullptr); }
    }
    SEAM(0);

#pragma unroll 1
    for (int l = 0; l < DEPTH; ++l) {
        const int pb = 1 + l * PH_PER_LAYER;
        if (PHM(1) && IN(pb + 0)) { PH_IDS()
            pg8::Gemm g{Hb, (const bf16*)(ws + WS_WIN) + (size_t)l * ZLD * DM, DM, DM, DM, 0}; pg8::LinOrder S{ZLD / 256, (NTOK / 256) * (ZLD / 256), G, vcu};
            EpiZ E{Zb, SSQ}; pg8::gemm_phase<EpiZ, pg8::LinOrder>(lds, g, S, E, tid);
        }
        SEAM(pb + 0);
        if (PHM(2) && IN(pb + 1)) { PH_IDS()
            if (SUBM & 1) { pg8::Gemm g{Zb, (const bf16*)(ws + WS_WUQ + l * MiB), ZLD, QLORA, QLORA, 0}; pg8::LinOrder S{3, (NTOK / 256) * 3, G, vcu};
              EpiQ E{Qb, SSQ}; pg8::gemm_phase<EpiQ, pg8::LinOrder>(lds, g, S, E, tid); }
            asm volatile("" : "+v"(tid));
            if (SUBM & 2) { pg8::Gemm g{Zb + QLORA, (const bf16*)(ws + WS_WUKV + l * MiB), ZLD, KVLORA, KVLORA, 0}; pg8::KvOrder S{G, vcu};
              EpiKV E{Kb, Vb, Zb, SSQ, RCOS, RSIN, tid}; pg8::gemm_phase<EpiKV, pg8::KvOrder>(lds, g, S, E, tid); }
            asm volatile("" : "+v"(tid));
            if (SUBM & 4) { const float* wc = AP->w_conv + (size_t)l * 3 * 256; const int gt = vcu * (NWAVES * 64) + tid, NGT = G * NWAVES * 64;
              for (int i = gt; i < NTOK * 32; i += NGT) { const int t = i >> 5, c0 = (i & 31) * 8, s = t & (SEQ - 1); const bf16* zr = Zb + (size_t)t * ZLD;
                  const v4u bb = *(const v4u*)(zr + ZC_B + c0), c1 = *(const v4u*)(zr + ZC_C + c0), h1 = *(const v4u*)(zr + ZC_H + c0);
                  v4u cm = {0u, 0u, 0u, 0u}, hm = cm, cp = cm, hp = cm;
                  if (s > 0) { cm = *(const v4u*)(zr - ZLD + ZC_C + c0); hm = *(const v4u*)(zr - ZLD + ZC_H + c0); }
                  if (s < SEQ - 1) { cp = *(const v4u*)(zr + ZLD + ZC_C + c0); hp = *(const v4u*)(zr + ZLD + ZC_H + c0); }
                  float o[8];
#pragma unroll
                  for (int q = 0; q < 4; ++q) {
                      const float w0a = wc[c0 + 2 * q], w1a = wc[256 + c0 + 2 * q], w2a = wc[512 + c0 + 2 * q], w0b = wc[c0 + 2 * q + 1], w1b = wc[256 + c0 + 2 * q + 1], w2b = wc[512 + c0 + 2 * q + 1];
                      o[2 * q] = bf_lo(bb[q]) * (w0a * bf_lo(cm[q]) * bf_lo(hm[q]) + w1a * bf_lo(c1[q]) * bf_lo(h1[q]) + w2a * bf_lo(cp[q]) * bf_lo(hp[q]));
                      o[2 * q + 1] = bf_hi(bb[q]) * (w0b * bf_hi(cm[q]) * bf_hi(hm[q]) + w1b * bf_hi(c1[q]) * bf_hi(h1[q]) + w2b * bf_hi(cp[q]) * bf_hi(hp[q])); }
                  v4u w; w.x = cvt_pk_bf16(o[0], o[1]); w.y = cvt_pk_bf16(o[2], o[3]); w.z = cvt_pk_bf16(o[4], o[5]); w.w = cvt_pk_bf16(o[6], o[7]);
                  *(v4u*)(Ob + (size_t)t * DM + 512 + c0) = w; } }
            __syncthreads();
            asm volatile("" : "+v"(tid));
            if (SUBM & 8) for (int u = vcu; u < BATCH * 128; u += G) fft::fft_unit<1>(u >> 7, u & 127, Zb, Ub, Ob, FA1, TW, (LAS char*)lds, tid);
        }
        SEAM(pb + 1);
        if (PHM(3) && IN(pb + 2)) { PH_IDS()
            if (SUBM & 1) for (int u = vcu; u < BATCH * 128; u += G) fft::fft_unit<2>(u >> 7, u & 127, Zb, Ub, Ob, FA2, TW, (LAS char*)lds, tid);
            asm volatile("" : "+v"(tid));
            if (SUBM & 2) for (int L = vcu; L < BATCH * NH * (SEQ / 256); L += G) { const int bh = L >> 6, qb = L & 63, b = bh >> 3, h = bh & 7;
                att::attn_unit(Qb + ((size_t)bh * SEQ + qb * 256) * DQK, Kb + (size_t)bh * SEQ * DQK, Vb + (size_t)bh * SEQ * DV, Ob + ((size_t)b * SEQ + qb * 256) * DM + h * DV, (LAS char*)lds, tid, RCOS, RSIN, qb * 256); }
        }
        SEAM(pb + 2);
#if PROBE_CHECK == 1 || PROBE_CHECK == 2
        { PH_IDS()
          if (PROBE_CHECK == 1) probe_qkv(AP, l, (vcu * 977 + 131 * l) & (NTOK - 1), Zb, Qb, Kb, Vb, ctl, (LAS float*)lds, tid);
          else probe_attn(vcu & 15, (vcu * 1021 + 77 + 4000 * l) & (SEQ - 1), Qb, Kb, Vb, Ob, ctl, (LAS float*)lds, tid);
          GRID_BAR(); }
#endif
        if (PHM(4) && IN(pb + 3)) { PH_IDS()
            pg8::Gemm g{Ob, (const bf16*)(ws + WS_WOUT) + (size_t)l * DM * DM, DM, DM, DM, 0}; pg8::LinOrder S{4, (NTOK / 256) * 4, G, vcu};
            EpiOut E{Y1}; pg8::gemm_phase<EpiOut, pg8::LinOrder>(lds, g, S, E, tid);
        }
        SEAM(pb + 3);
        if (PHM(5) && IN(pb + 4)) { PH_IDS()
            bf16* hout = (SUBM & 16) ? Ob : Hb;
            for (int m0 = 2 * gw; m0 < NTOK; m0 += 2 * NGW) { float va[16], vb[16];
#pragma unroll
                for (int j = 0; j < 2; ++j) { const size_t eo = (size_t)m0 * DM + 8 * lane + 512 * j;
                    const v4u ha = *(const v4u*)(Hb + eo), ya = *(const v4u*)(Y1 + eo), hb = *(const v4u*)(Hb + eo + DM), yb = *(const v4u*)(Y1 + eo + DM);
                    float fh[8], fy[8]; unpack8(ha, fh); unpack8(ya, fy);
#pragma unroll
                    for (int i = 0; i < 8; ++i) va[8 * j + i] = fy[i] + ALPHA * fh[i];
                    unpack8(hb, fh); unpack8(yb, fy);
#pragma unroll
                    for (int i = 0; i < 8; ++i) vb[8 * j + i] = fy[i] + ALPHA * fh[i]; }
                ln16(va, AP->ln1_g + l * DM, AP->ln1_b + l * DM, lane, hout + (size_t)m0 * DM, nullptr); ln16(vb, AP->ln1_g + l * DM, AP->ln1_b + l * DM, lane, hout + (size_t)(m0 + 1) * DM, nullptr); }
        }
        SEAM(pb + 4);
        if (PHM(6) && IN(pb + 5)) { PH_IDS()
            pg8::Gemm g{Hb, (const bf16*)(ws + WS_WR) + (size_t)l * 256 * DM, DM, DM, DM, 0}; pg8::LinOrder S{1, NTOK / 256, G, vcu};
            EpiLogits E{LG}; pg8::gemm_phase<EpiLogits, pg8::LinOrder>(lds, g, S, E, tid);
        }
        SEAM(pb + 5);
        if (PHM(7) && IN(pb + 6)) { PH_IDS()
            LAS int* lcnt = (LAS int*)(lds + RT_OFF); int* CNTS = (int*)(ws + WS_CNTS);
            for (int ch = vcu; ch < NTOK / 128; ch += G) {
                if (tid < 32) lcnt[tid] = 0;
                __syncthreads();
                int e1 = 0, e2 = 0, r1 = 0, r2 = 0; float w1 = 0.f, w2 = 0.f; const int t = ch * 128 + tid;
                if (tid < 128) {
                    const float* lg = LG + (size_t)t * 64; float gl[4]; int gi = 0;
#pragma unroll
                    for (int i = 0; i < 4; ++i) gl[i] = lg[i] + AP->b_group[l * 4 + i];
                    float gmax = gl[0];
#pragma unroll
                    for (int i = 1; i < 4; ++i) if (gl[i] > gmax) { gmax = gl[i]; gi = i; }
                    float gs = 0.f;
#pragma unroll
                    for (int i = 0; i < 4; ++i) gs += __expf(gl[i] - gmax);
                    const float pg = 1.0f / gs;
                    float el[8];
#pragma unroll
                    for (int i = 0; i < 8; ++i) el[i] = lg[4 + 8 * gi + i] + AP->b_router[l * 32 + 8 * gi + i];
                    int i1 = 0; float m1 = el[0];
#pragma unroll
                    for (int i = 1; i < 8; ++i) if (el[i] > m1) { m1 = el[i]; i1 = i; }
                    int i2 = 0; float m2 = -3.0e38f;
#pragma unroll
                    for (int i = 0; i < 8; ++i) if (i != i1 && el[i] > m2) { m2 = el[i]; i2 = i; }
                    const float x2 = __expf(m2 - m1); const float p1 = 1.0f / (1.0f + x2);
                    w1 = p1 * pg; w2 = (1.0f - p1) * pg; e1 = 8 * gi + i1; e2 = 8 * gi + i2;
                    r1 = atomicAdd((int*)&lcnt[e1], 1); r2 = atomicAdd((int*)&lcnt[e2], 1);
                }
                __syncthreads();
                if (tid < 32) CNTS[((size_t)l * 256 + ch) * 32 + tid] = lcnt[tid];
                if (tid < 128) { v4u o; o.x = (unsigned)e1 | ((unsigned)r1 << 8); o.y = (unsigned)e2 | ((unsigned)r2 << 8); o.z = __float_as_uint(w1); o.w = __float_as_uint(w2); TOK[t] = o; }
                __syncthreads();
            }
        }
        SEAM(pb + 6);
        LAS int* pre = (LAS int*)lds; LAS int* segc = seg + 40;
        if (IN(pb + 7)) { PH_IDS()
            const int* CN = (const int*)(ws + WS_CNTS) + (size_t)l * 256 * 32;
            for (int i = tid; i < 256 * 32 / 4; i += NWAVES * 64) *(LAS v4u*)(pre + 4 * i) = *(const v4u*)(CN + 4 * i);
            __syncthreads();
            if (tid < 32) { int acc = 0; for (int ch = 0; ch < 256; ++ch) { const int c = pre[ch * 32 + tid]; pre[ch * 32 + tid] = acc; acc += c; } segc[tid] = acc; }
            __syncthreads();
            if (tid == 0) { int acc = 0; for (int e = 0; e < NEXP; ++e) { seg[e] = acc; acc += (segc[e] + 255) >> 8; } seg[32] = acc; }
            __syncthreads();
        } else if (IN(pb + 8) || IN(pb + 9)) { PH_IDS()
            const int* CN = (const int*)(ws + WS_CNTS) + (size_t)l * 256 * 32;
            if (tid < 32) { int acc = 0; for (int ch = 0; ch < 256; ++ch) acc += CN[ch * 32 + tid]; segc[tid] = acc; }
            __syncthreads();
            if (tid == 0) { int acc = 0; for (int e = 0; e < NEXP; ++e) { seg[e] = acc; acc += (segc[e] + 255) >> 8; } seg[32] = acc; }
            __syncthreads();
        }
        if (PHM(8) && IN(pb + 7)) { PH_IDS()
            for (int t0 = 2 * gw; t0 < NTOK; t0 += 2 * NGW) { const v4u ti = TOK[t0], tj = TOK[t0 + 1];
                const int a1 = seg[ti.x & 255] * 256 + pre[(t0 >> 7) * 32 + (ti.x & 255)] + (int)(ti.x >> 8), a2 = seg[ti.y & 255] * 256 + pre[(t0 >> 7) * 32 + (ti.y & 255)] + (int)(ti.y >> 8);
                const int b1 = seg[tj.x & 255] * 256 + pre[(t0 >> 7) * 32 + (tj.x & 255)] + (int)(tj.x >> 8), b2 = seg[tj.y & 255] * 256 + pre[(t0 >> 7) * 32 + (tj.y & 255)] + (int)(tj.y >> 8);
                const bf16* ha = Hb + (size_t)t0 * DM + 8 * lane; const v4u x0 = *(const v4u*)ha, x1 = *(const v4u*)(ha + 512), y0 = *(const v4u*)(ha + DM), y1 = *(const v4u*)(ha + DM + 512);
                *(v4u*)(XG + (size_t)a1 * DM + 8 * lane) = x0; *(v4u*)(XG + (size_t)a1 * DM + 512 + 8 * lane) = x1; *(v4u*)(XG + (size_t)a2 * DM + 8 * lane) = x0; *(v4u*)(XG + (size_t)a2 * DM + 512 + 8 * lane) = x1;
                *(v4u*)(XG + (size_t)b1 * DM + 8 * lane) = y0; *(v4u*)(XG + (size_t)b1 * DM + 512 + 8 * lane) = y1; *(v4u*)(XG + (size_t)b2 * DM + 8 * lane) = y0; *(v4u*)(XG + (size_t)b2 * DM + 512 + 8 * lane) = y1;
                if (lane == 0) { ROWTOK[a1] = 2 * t0; ROWW[a1] = __uint_as_float(ti.z); ROWTOK[a2] = 2 * t0 + 1; ROWW[a2] = __uint_as_float(ti.w);
                                 ROWTOK[b1] = 2 * t0 + 2; ROWW[b1] = __uint_as_float(tj.z); ROWTOK[b2] = 2 * t0 + 3; ROWW[b2] = __uint_as_float(tj.w); } }
            for (int e = vcu; e < NEXP; e += G) { const int c = segc[e];
                for (int r = seg[e] * 256 + c + tid; r < seg[e + 1] * 256; r += NWAVES * 64) { ROWTOK[r] = -1; ROWW[r] = 0.f; } }
        }
        SEAM(pb + 7);
        if (PHM(9) && IN(pb + 8)) { PH_IDS()
            pg8::Gemm g{XG, (const bf16*)(ws + WS_WGU) + (size_t)l * NEXP * 512 * DM, DM, DM, DM, (size_t)512 * DM * 2}; pg8::MoeOrder S{2, seg[32] * 2, G, vcu, seg};
            EpiGU E{HID, ROWW}; pg8::gemm_phase<EpiGU, pg8::MoeOrder>(lds, g, S, E, tid);
            if (l + 1 < DEPTH) { const int total = seg[32] * 2, busy = total % G;
                if (vcu >= busy) { LAS float* scr = (LAS float*)(lds + wave * 16384); const int np = G - busy, gwp = (vcu - busy) * NWAVES + wave, ngwp = np * NWAVES; const int l1 = l + 1;
                    __syncthreads();
                    for (int it = gwp; it < NEXP * 256; it += ngwp) { const int le = l1 * NEXP + it / 256, r = it % 256, kb = r / 16, nb = r % 16; const int n0 = 32 * nb, pn = n0 >> 8, j0 = n0 & 255;
                        const float* W = ((j0 < 128) ? AP->w_gate : AP->w_up) + (size_t)le * DM * DEXP; const int src0 = 128 * pn + (j0 & 127);
                        tr_item([&](int k, int n) { return *(const f32x4*)(W + (size_t)k * DEXP + src0 + (n - n0)); }, (bf16*)(ws + WS_WGU) + (size_t)le * 512 * DM, DM, 64 * kb, n0, scr, lane); }
                    for (int it = gwp; it < NEXP * 128; it += ngwp) { const int le = l1 * NEXP + it / 128, r = it % 128, kb = r / 32, nb = r % 32; const float* W = AP->w_down + (size_t)le * DEXP * DM;
                        tr_item([&](int k, int n) { return *(const f32x4*)(W + (size_t)k * DM + n); }, (bf16*)(ws + WS_WD) + (size_t)le * DM * DEXP, DEXP, 64 * kb, 32 * nb, scr, lane); } } }
        }
        SEAM(pb + 8);
        if (PHM(10) && IN(pb + 9)) { PH_IDS()
            pg8::Gemm g{HID, (const bf16*)(ws + WS_WD) + (size_t)l * NEXP * DM * DEXP, DEXP, DEXP, DEXP, (size_t)DM * DEXP * 2}; pg8::MoeOrder S{4, seg[32] * 4, G, vcu, seg};
            EpiDown E{PARTS, ROWTOK}; pg8::gemm_phase<EpiDown, pg8::MoeOrder>(lds, g, S, E, tid);
        }
        SEAM(pb + 9);
#if PROBE_CHECK == 3 || PROBE_CHECK == 4
        { PH_IDS()
          probe_moe(AP, l, (vcu * 977 + 131 * l + 5) & (NTOK - 1), Hb, TOK, PARTS, ctl, (LAS float*)lds, tid);
          GRID_BAR(); }
#endif
        if (PHM(11) && IN(pb + 10)) { PH_IDS()
            const bool lastl = (l == DEPTH - 1); const bool dry = (SUBM & 16) != 0;
            for (int m0 = 2 * gw; m0 < NTOK; m0 += 2 * NGW) { float va[16], vb[16];
#pragma unroll
                for (int j = 0; j < 2; ++j) { const size_t eo = (size_t)m0 * DM + 8 * lane + 512 * j, po = (size_t)(2 * m0) * DM + 8 * lane + 512 * j;
                    const v4u ha = *(const v4u*)(Hb + eo), hb = *(const v4u*)(Hb + eo + DM);
                    const v4u pa0 = *(const v4u*)(PARTS + po), pa1 = *(const v4u*)(PARTS + po + DM), pb0 = *(const v4u*)(PARTS + po + 2 * DM), pb1 = *(const v4u*)(PARTS + po + 3 * DM);
                    float fh[8], f0[8], f1[8]; unpack8(ha, fh); unpack8(pa0, f0); unpack8(pa1, f1);
#pragma unroll
                    for (int i = 0; i < 8; ++i) va[8 * j + i] = ALPHA * fh[i] + (f0[i] + f1[i]);
                    unpack8(hb, fh); unpack8(pb0, f0); unpack8(pb1, f1);
#pragma unroll
                    for (int i = 0; i < 8; ++i) vb[8 * j + i] = ALPHA * fh[i] + (f0[i] + f1[i]); }
                asm volatile("s_waitcnt vmcnt(0)" ::: "memory");
                if (lastl) { float* ob = (dry ? (float*)Zb : AP->out) + (size_t)m0 * DM; ln16(va, AP->ln2_g + l * DM, AP->ln2_b + l * DM, lane, nullptr, ob); ln16(vb, AP->ln2_g + l * DM, AP->ln2_b + l * DM, lane, nullptr, ob + DM); }
                else { bf16* ob = (dry ? Zb : Hb) + (size_t)m0 * DM; ln16(va, AP->ln2_g + l * DM, AP->ln2_b + l * DM, lane, ob, nullptr); ln16(vb, AP->ln2_g + l * DM, AP->ln2_b + l * DM, lane, ob + DM, nullptr); } }
        }
        if (l + 1 < DEPTH) SEAM(pb + 10);
    }
#if PROBE_CHECK
    { GRID_BAR(); PH_IDS()
      float dg = __uint_as_float(__hip_atomic_load((unsigned*)(ctl + CW_DIAG), RLX_AGENT));
      if (PROBE_CHECK == 4) dg = (float)__hip_atomic_load((unsigned*)(ctl + CW_DIAG2), RLX_AGENT) * (1.0f / 512.0f);
      const float sc = 1.0f + 10.0f * dg;
      for (int m = gw; m < NTOK; m += NGW) { f32x4* o = (f32x4*)(AP->out + (size_t)m * DM) + lane;
#pragma unroll
          for (int j = 0; j < 4; ++j) o[64 * j] = o[64 * j] * sc; } }
#endif
#undef IN
#undef SEAM
}

extern "C" void kernel_launch(void* const* d_in, const int* in_sizes, int n_in, void* d_out, int out_size, void* d_ws, size_t ws_size, hipStream_t stream) {
    static int grid = 0;
    if (grid == 0) {
        if (n_in != 21 || in_sizes[0] != NTOK * DM || out_size != NTOK * DM || ws_size < WS_END) { fprintf(stderr, "kernel_launch: shape/workspace mismatch (n_in %d, in0 %d, out %d, ws %zu, need %zu)\n", n_in, n_in > 0 ? in_sizes[0] : -1, out_size, ws_size, (size_t)WS_END); grid = -1; return; }
        int dev = 0, cus = 0, per_cu = 0;
        if (hipGetDevice(&dev) != hipSuccess || hipDeviceGetAttribute(&cus, hipDeviceAttributeMultiprocessorCount, dev) != hipSuccess) { grid = -1; return; }
        if (hipFuncSetAttribute((const void*)fwd, hipFuncAttributeMaxDynamicSharedMemorySize, LDS_BYTES) != hipSuccess) { fprintf(stderr, "kernel_launch: hipFuncSetAttribute failed\n"); grid = -1; return; }
        if (hipOccupancyMaxActiveBlocksPerMultiprocessor(&per_cu, (const void*)fwd, NWAVES * 64, LDS_BYTES) != hipSuccess || per_cu < 1) { fprintf(stderr, "kernel_launch: occupancy query says %d\n", per_cu); }
        (void)hipGetLastError();
        grid = cus;
    }
    if (grid < 0) return;
    if (hipMemsetAsync((char*)d_ws + WS_CTL, 0, CTL_ZERO_BYTES, stream) != hipSuccess) return;
    Args a{};
    const float** ap = (const float**)&a;
    for (int i = 0; i < 21; ++i) ap[i] = (const float*)d_in[i];
    a.out = (float*)d_out; a.ws = (unsigned char*)d_ws; a.sub = 0xF;
#if MK_PER_PHASE
#ifndef REP_SUB
#define REP_SUB 0xF
#endif
#ifndef REP_MASK
#define REP_MASK 0
#endif
    for (int p = 0; p < N_PHASES; ++p) { a.ph_lo = p; a.ph_hi = p + 1; const int j = p == 0 ? 0 : (p - 1) % PH_PER_LAYER + 1;
        for (int rep = 0; rep < (((REP_MASK >> j) & 1) ? 2 : 1); ++rep) { a.sub = rep ? REP_SUB : 0xF; hipLaunchKernelGGL(fwd, dim3(grid), dim3(NWAVES * 64), LDS_BYTES, stream, a); } a.sub = 0xF; }
#else
    a.ph_lo = 0; a.ph_hi = N_PHASES; hipLaunchKernelGGL(fwd, dim3(grid), dim3(NWAVES * 64), LDS_BYTES, stream, a);
#endif
    const hipError_t le = hipPeekAtLastError();
    if (le != hipSuccess) fprintf(stderr, "kernel_launch: launch failed: %s\n", hipGetErrorName(le));
}
```

```cpp
#include <hip/hip_runtime.h>
#include <cstdio>
#include <cstdint>

#ifndef MK_PER_PHASE
#define MK_PER_PHASE 0
#endif

#ifndef PROBE_CHECK
#define PROBE_CHECK 0
#endif
#define GAS __attribute__((address_space(1)))
#define LAS __attribute__((address_space(3)))
typedef unsigned short bf16;
typedef unsigned v4u __attribute__((ext_vector_type(4)));
typedef unsigned v2u __attribute__((ext_vector_type(2)));
typedef float f32x4 __attribute__((ext_vector_type(4)));
typedef float f32x16 __attribute__((ext_vector_type(16)));
typedef short bf16x8 __attribute__((ext_vector_type(8)));
typedef short s16x4 __attribute__((ext_vector_type(4)));
typedef GAS unsigned gu32;
#define RLX_AGENT __ATOMIC_RELAXED, __HIP_MEMORY_SCOPE_AGENT
#define LDS_WAIT() asm volatile("s_waitcnt lgkmcnt(0)" ::: "memory")
#define VM_WAIT() asm volatile("s_waitcnt vmcnt(0)" ::: "memory")

constexpr int BATCH = 2, SEQ = 16384, DM = 1024, NTOK = BATCH * SEQ, DEPTH = 2;
constexpr int NH = 8, DNOPE = 64, DROPE = 32, DQK = 96, DV = 64, QLORA = 384, KVLORA = 256;
constexpr int DIN = 1696, ZLD = 2048;
constexpr int ZC_KPE = 640, ZC_B = 768, ZC_C = 1024, ZC_H = 1280, ZC_FR = 1536;
constexpr int NEXP = 32, DEXP = 256;
constexpr float LN_EPS = 1e-5f, RMS_EPS = 1e-6f;
constexpr float ALPHA = 1.4142135623730951f;
constexpr float QSCALE = 0.10206207261596577f * 1.4426950408889634f;
constexpr int MAXROWS = 73728;

constexpr size_t MiB = 1u << 20;
constexpr size_t WS_CTL = 0, CTL_ZERO_BYTES = 32 * 1024;
constexpr size_t WS_WIN = 1 * MiB;
constexpr size_t WS_WUQ = 9 * MiB;
constexpr size_t WS_WUKV = 11 * MiB;
constexpr size_t WS_WOUT = 13 * MiB;
constexpr size_t WS_WR = 17 * MiB;
constexpr size_t WS_WGU = 18 * MiB;
constexpr size_t WS_WD = 82 * MiB;
constexpr size_t WS_ROPE = 114 * MiB;
constexpr size_t WS_FA1 = 116 * MiB;
constexpr size_t WS_SSQ = 117 * MiB;
constexpr size_t WS_LG = 120 * MiB;
constexpr size_t WS_TOK = 128 * MiB;
constexpr size_t WS_CNTS = 128 * MiB + 512 * 1024;
constexpr size_t WS_ROWTOK = 129 * MiB;
constexpr size_t WS_H = 130 * MiB;
constexpr size_t WS_Z = 194 * MiB;
constexpr size_t WS_V = 338 * MiB;
constexpr size_t WS_O = 370 * MiB;
constexpr size_t WS_END = 434 * MiB;
constexpr size_t DO_Q = 0, DO_K = 48 * MiB, DO_U = 96 * MiB;
constexpr int CW_DIAG = 16, CW_DIAG2 = 17; constexpr int CW_TMO = 0, CW_BAR = 4096;
static_assert((CW_BAR + 3456) * 4 <= (int)CTL_ZERO_BYTES, "barrier words inside the per-call memset");

constexpr int RING_BYTES = 131072;
constexpr int LDSCTL_OFF = RING_BYTES, MISC_OFF = LDSCTL_OFF + 320;
constexpr int SEG_OFF = MISC_OFF + 128;
constexpr int RT_OFF = SEG_OFF + 512;
constexpr int GIDX_OFF = 133120;
constexpr int LDS_BYTES = 147456;
static_assert(RT_OFF + 256 <= GIDX_OFF && GIDX_OFF + 3 * 1024 <= LDS_BYTES, "LDS map (gidx)");
static_assert(RT_OFF + 256 <= LDS_BYTES, "LDS map");
constexpr int NWAVES = 8;

__device__ __forceinline__ unsigned cvt_pk_bf16(float lo, float hi) { unsigned r; asm volatile("v_cvt_pk_bf16_f32 %0, %1, %2" : "=v"(r) : "v"(lo), "v"(hi)); return r; }
__device__ __forceinline__ float bf_lo(unsigned w) { return __uint_as_float(w << 16); }
__device__ __forceinline__ float bf_hi(unsigned w) { return __uint_as_float(w & 0xffff0000u); }
__device__ __forceinline__ float wave_sum(float v) {
#pragma unroll
    for (int o = 1; o < 64; o <<= 1) v += __shfl_xor(v, o);
    return v;
}

namespace pg8 {
typedef unsigned short bf16_t;
constexpr int BM = 256, BK = 64, HALF = 128, HTB = HALF * BK * 2, STAGE_BYTES = 8 * HTB;
__host__ __device__ __forceinline__ int lds_byte(int r, int c) { const int st = (r >> 4) * 2 + (c >> 5), rr = r & 15, cc = c & 31, ob = rr * 64 + cc * 2; return st * 1024 + (ob ^ (((ob >> 9) & 1) << 5)); }
__host__ __device__ __forceinline__ void stage_rc(int b, int& R, int& C) { const int st = b / 1024, sb = b % 1024, swz = sb ^ (((sb >> 9) & 1) << 5); R = (st >> 1) * 16 + swz / 64; C = (st & 1) * 32 + (swz % 64) / 2; }
__host__ __device__ __forceinline__ int perm32(int rho) { const int n = rho >> 4, i = rho & 15; return 8 * (i >> 2) + 4 * n + (i & 3); }

struct Unit { int pm, pn, e; };
struct Gemm { const bf16_t* A; const bf16_t* Bt; int lda, ldb, K; size_t estride; };

template <class Epi, class Sched>
__device__ __forceinline__ void gemm_phase(LAS unsigned char* lds, const Gemm g, const Sched& S, const Epi& E, const int tid) {
    const int wid = __builtin_amdgcn_readfirstlane(tid >> 6), lane = tid & 63, wr = wid >> 2, wc = wid & 3, fr = lane & 15, fq = lane >> 4;
    const int K = g.K, nt = K / BK;
    unsigned voffA[2], voffB[2]; int gR[2]; unsigned gC[2];
#pragma unroll
    for (int i = 0; i < 2; ++i) { int R, C; stage_rc(tid * 16 + i * 8192, R, C); const int Rb = Epi::PERM ? ((R & ~31) + perm32(R & 31)) : R;
        voffA[i] = (unsigned)(R * g.lda + C) * 2u; voffB[i] = (unsigned)(Rb * g.ldb + C) * 2u; gR[i] = R; gC[i] = (unsigned)C * 2u; }
    unsigned vo[2][2], nvo[2][2];
    auto gofs = [&](int unit_i, unsigned (&o)[2][2]) __attribute__((always_inline)) {
        if constexpr (Sched::GATHER) {
#pragma unroll
            for (int h = 0; h < 2; ++h)
#pragma unroll
                for (int i = 0; i < 2; ++i) { const int v = S.gidx[unit_i * 256 + h * 128 + gR[i]]; o[h][i] = (unsigned)v * (unsigned)(g.lda * 2) + gC[i]; } } };
    const size_t kstep = (size_t)(BK * 2);
    const size_t hstepA = (size_t)HALF * g.lda * 2, hstepB = (size_t)HALF * g.ldb * 2;
    const size_t tstepA = 2 * hstepA, tstepB = 2 * hstepB;
    const unsigned ldsw = (unsigned)wid * 1024u;
    const int aoff = lds_byte(wr * 64 + fr, fq * 8), boff = lds_byte(wc * 32 + fr, fq * 8);
#define PG8_SA(b, h) (((b) * 2 + (h)) * HTB)
#define PG8_SB(b, h) ((4 + (b) * 2 + (h)) * HTB)
#define PG8_STAGE(bufoff, gbase, voff) do { _Pragma("unroll") for (int _i = 0; _i < 2; ++_i) \
        __builtin_amdgcn_global_load_lds((const unsigned*)((const char*)(gbase) + (voff)[_i]), (LAS unsigned*)(lds + (bufoff) + ldsw + _i * 8192), 16, 0, 0); } while (0)
#define PG8_STAGE_A(bufoff, kptr, hh, NX) do { if constexpr (Sched::GATHER) { _Pragma("unroll") for (int _i = 0; _i < 2; ++_i) \
        __builtin_amdgcn_global_load_lds((const unsigned*)((const char*)(kptr) + ((NX) ? nvo[hh][_i] : vo[hh][_i])), (LAS unsigned*)(lds + (bufoff) + ldsw + _i * 8192), 16, 0, 0); } \
      else PG8_STAGE(bufoff, (kptr) + (hh) * hstepA, voffA); } while (0)
#define PG8_LDA(dst, b, h) do { _Pragma("unroll") for (int m = 0; m < 4; ++m) _Pragma("unroll") for (int k = 0; k < 2; ++k) dst[m][k] = *(const LAS bf16x8*)(lds + PG8_SA(b, h) + aoff + m * 2048 + k * 1024); } while (0)
#define PG8_LDB(dst, b, h) do { _Pragma("unroll") for (int n = 0; n < 2; ++n) _Pragma("unroll") for (int k = 0; k < 2; ++k) dst[n][k] = *(const LAS bf16x8*)(lds + PG8_SB(b, h) + boff + n * 2048 + k * 1024); } while (0)
#define PG8_MMA(ai, bj, At, Bt) do { __builtin_amdgcn_s_setprio(1); _Pragma("unroll") for (int m = 0; m < 4; ++m) _Pragma("unroll") for (int n = 0; n < 2; ++n) _Pragma("unroll") for (int k = 0; k < 2; ++k) \
        acc[ai][bj][m][n] = __builtin_amdgcn_mfma_f32_16x16x32_bf16(Bt[n][k], At[m][k], acc[ai][bj][m][n], 0, 0, 0); __builtin_amdgcn_s_setprio(0); } while (0)
#define PG8_WAIT_V(n) asm volatile("s_waitcnt vmcnt(" #n ")" ::: "memory")
#define PG8_WAIT_L(n) asm volatile("s_waitcnt lgkmcnt(" #n ")" ::: "memory")
#define PG8_BAR __builtin_amdgcn_s_barrier()
#define PG8_SCHED __builtin_amdgcn_sched_barrier(0)
    Unit cur, nxt; int ui = 0;
    if (!S.next(0, cur)) return;
    f32x4 acc[2][2][4][2];
#pragma unroll
    for (int a = 0; a < 2; ++a)
#pragma unroll
        for (int b = 0; b < 2; ++b)
#pragma unroll
            for (int m = 0; m < 4; ++m)
#pragma unroll
                for (int n = 0; n < 2; ++n) acc[a][b][m][n] = (f32x4){0.f, 0.f, 0.f, 0.f};
    bf16x8 At[4][2], B0[2][2], B1[2][2];
    if constexpr (Sched::GATHER) gofs(0, vo);
    const char* cA = (const char*)g.A + (Sched::GATHER ? (size_t)0 : (size_t)cur.pm * tstepA); const char* cB = (const char*)g.Bt + (size_t)cur.e * g.estride + (size_t)cur.pn * tstepB;
    PG8_STAGE(PG8_SB(0, 0), cB, voffB); PG8_STAGE(PG8_SB(0, 1), cB + hstepB, voffB); PG8_STAGE_A(PG8_SA(0, 0), cA, 0, false); PG8_STAGE_A(PG8_SA(0, 1), cA, 1, false);
    if (wr == 1) PG8_BAR;
    PG8_WAIT_V(2); PG8_BAR;
    PG8_STAGE(PG8_SB(1, 0), cB + kstep, voffB); PG8_STAGE_A(PG8_SA(1, 0), cA + kstep, 0, false); PG8_STAGE(PG8_SB(1, 1), cB + hstepB + kstep, voffB);
    PG8_WAIT_V(6); PG8_BAR;
    for (;;) {
        const bool has_next = S.next(ui + 1, nxt);
        if constexpr (Sched::GATHER) { if (has_next) gofs(ui + 1, nvo); else {
#pragma unroll
            for (int h = 0; h < 2; ++h) { nvo[h][0] = vo[h][0]; nvo[h][1] = vo[h][1]; } } }
        const char* nA = (has_next && !Sched::GATHER) ? (const char*)g.A + (size_t)nxt.pm * tstepA : cA;
        const char* nB = has_next ? (const char*)g.Bt + (size_t)nxt.e * g.estride + (size_t)nxt.pn * tstepB : cB;
#pragma unroll 1
        for (int t = 0; t < nt; t += 2) {
            const bool last = (t == nt - 2);
            const char* a1 = cA + (size_t)(t + 1) * kstep;
            const char* a2 = last ? nA : cA + (size_t)(t + 2) * kstep; const char* b2 = last ? nB : cB + (size_t)(t + 2) * kstep;
            const char* a3 = a2 + kstep; const char* b3 = b2 + kstep;
            PG8_LDB(B0, 0, 0); PG8_LDB(B1, 0, 1); PG8_SCHED; PG8_LDA(At, 0, 0); PG8_STAGE_A(PG8_SA(1, 1), a1, 1, false);
            PG8_WAIT_V(8); PG8_WAIT_L(0); PG8_BAR; PG8_MMA(0, 0, At, B0); PG8_MMA(0, 1, At, B1); PG8_BAR; PG8_SCHED;
            PG8_LDA(At, 0, 1); PG8_STAGE(PG8_SB(0, 0), b2, voffB); PG8_STAGE(PG8_SB(0, 1), b2 + hstepB, voffB); PG8_STAGE_A(PG8_SA(0, 0), a2, 0, last);
            PG8_WAIT_V(8); PG8_WAIT_L(0); PG8_BAR; PG8_MMA(1, 0, At, B0); PG8_MMA(1, 1, At, B1); PG8_BAR; PG8_SCHED;
            PG8_LDB(B0, 1, 0); PG8_LDB(B1, 1, 1); PG8_SCHED; PG8_LDA(At, 1, 0); PG8_STAGE_A(PG8_SA(0, 1), a2, 1, last);
            PG8_WAIT_V(8); PG8_WAIT_L(0); PG8_BAR; PG8_MMA(0, 0, At, B0); PG8_MMA(0, 1, At, B1); PG8_BAR; PG8_SCHED;
            PG8_LDA(At, 1, 1); PG8_STAGE(PG8_SB(1, 0), b3, voffB); PG8_STAGE(PG8_SB(1, 1), b3 + hstepB, voffB); PG8_STAGE_A(PG8_SA(1, 0), a3, 0, last);
            PG8_WAIT_V(8); PG8_WAIT_L(0); PG8_BAR; PG8_MMA(1, 0, At, B0); PG8_MMA(1, 1, At, B1); PG8_BAR; PG8_SCHED;
        }
        if (wr == 0) PG8_BAR;
        E(acc, cur, wr, wc, fr, fq);
        if (!has_next) break;
#pragma unroll
        for (int a = 0; a < 2; ++a)
#pragma unroll
            for (int b = 0; b < 2; ++b)
#pragma unroll
                for (int m = 0; m < 4; ++m)
#pragma unroll
                    for (int n = 0; n < 2; ++n) acc[a][b][m][n] = (f32x4){0.f, 0.f, 0.f, 0.f};
        cur = nxt; cA = nA; cB = nB; ++ui;
        if constexpr (Sched::GATHER) {
#pragma unroll
            for (int h = 0; h < 2; ++h) { vo[h][0] = nvo[h][0]; vo[h][1] = nvo[h][1]; } }
        if (wr == 1) PG8_BAR;
    }
    PG8_WAIT_V(0);
    PG8_BAR;
#undef PG8_SA
#undef PG8_SB
#undef PG8_STAGE
#undef PG8_STAGE_A
#undef PG8_LDA
#undef PG8_LDB
#undef PG8_MMA
#undef PG8_WAIT_V
#undef PG8_WAIT_L
#undef PG8_BAR
#undef PG8_SCHED
}

struct LinOrder {
    static constexpr bool GATHER = false;
    int nN, total, G, c;
    __device__ __forceinline__ bool next(int i, Unit& u) const { const int L = i * G + c; if (L >= total) return false; u.pm = L / nN; u.pn = L - u.pm * nN; u.e = 0; return true; }
};
struct KvOrder {
    static constexpr bool GATHER = false;
    int G, c;
    __device__ __forceinline__ bool next(int i, Unit& u) const {
        int L;
        if (G != 256) { L = i * G + c; if (L >= 512) return false; }
        else if (c < 128) { if (i > 0) return false; L = c; }
        else { if (i > 2) return false; L = 128 + (c - 128) * 3 + i; }
        u.pm = L >> 2; u.pn = L & 3; u.e = 0; return true; }
};
struct MoeOrder {
    static constexpr bool GATHER = false;
    int nN, total, G, c; const LAS int* seg;
    __device__ __forceinline__ bool next(int i, Unit& u) const { const int L = i * G + c; if (L >= total) return false; u.pm = L / nN; u.pn = L - u.pm * nN;
        int e = 0;
#pragma unroll 1
        for (int j = 1; j < NEXP; ++j) e += (seg[j] <= u.pm) ? 1 : 0;
        u.e = e; return true; }
};
struct MoeGatherOrder : MoeOrder { static constexpr bool GATHER = true; const LAS int* gidx; };
}

typedef float f32x2 __attribute__((ext_vector_type(2)));
typedef const f32x4 (&AccRef)[2][2][4][2];
#define EPI_FENCE() do { asm volatile("" ::: "memory"); __builtin_amdgcn_sched_barrier(0); } while (0)
struct EpiZ { static constexpr bool PERM = true;
    bf16* Z; float* ssq;
    __device__ __forceinline__ void operator()(AccRef acc, const pg8::Unit& u, int wr, int wc, int fr, int fq) const {
        const int row0 = u.pm * 256 + wr * 64 + fr, col0 = u.pn * 256 + wc * 32 + 8 * fq;
#pragma unroll
        for (int ai = 0; ai < 2; ++ai)
#pragma unroll
            for (int m = 0; m < 4; ++m) { const int row = row0 + ai * 128 + m * 16; bf16* rowp = Z + (size_t)row * ZLD + col0;
#pragma unroll
                for (int bj = 0; bj < 2; ++bj) { const f32x4 v0 = acc[ai][bj][m][0], v1 = acc[ai][bj][m][1];
                    v4u w; w.x = cvt_pk_bf16(v0[0], v0[1]); w.y = cvt_pk_bf16(v0[2], v0[3]); w.z = cvt_pk_bf16(v1[0], v1[1]); w.w = cvt_pk_bf16(v1[2], v1[3]);
                    *(v4u*)(rowp + bj * 128) = w;
                    const int grp = 2 * u.pn + bj;
                    if (grp < 5) { float s = (v0[0] * v0[0] + v0[1] * v0[1]) + (v0[2] * v0[2] + v0[3] * v0[3]) + (v1[0] * v1[0] + v1[1] * v1[1]) + (v1[2] * v1[2] + v1[3] * v1[3]);
                        s += __shfl_xor(s, 16); s += __shfl_xor(s, 32);
                        if (fq == 0) ssq[(size_t)row * 20 + grp * 4 + wc] = s; } } EPI_FENCE(); }
    }
};
__device__ __forceinline__ float ssq_sum(const float* p, int n4) { float s = 0.f; for (int i = 0; i < n4; ++i) { const f32x4 v = *(const f32x4*)(p + 4 * i); s += (v[0] + v[1]) + (v[2] + v[3]); } return s; }
struct EpiQ { static constexpr bool PERM = true;
    bf16* Q; const float* ssq;
    __device__ __forceinline__ void operator()(AccRef acc, const pg8::Unit& u, int wr, int wc, int fr, int fq) const {
        const int row0 = u.pm * 256 + wr * 64 + fr;
        float rq[8];
#pragma unroll
        for (int i = 0; i < 8; ++i) { const float* p = ssq + (size_t)(row0 + (i >> 2) * 128 + (i & 3) * 16) * 20 + 3 * fq; rq[i] = (p[0] + p[1]) + p[2]; }
#pragma unroll
        for (int i = 0; i < 8; ++i) { float s = rq[i]; s += __shfl_xor(s, 16); s += __shfl_xor(s, 32); rq[i] = QSCALE / sqrtf(s * (1.0f / QLORA) + RMS_EPS); }
#pragma unroll
        for (int ai = 0; ai < 2; ++ai)
#pragma unroll
            for (int m = 0; m < 4; ++m) { const int row = row0 + ai * 128 + m * 16, b = row / SEQ, s = row - b * SEQ; const float r = rq[ai * 4 + m];
#pragma unroll
                for (int bj = 0; bj < 2; ++bj) { const int c32 = 8 * u.pn + 4 * bj + wc, head = c32 / 3, part = c32 - 3 * head;
                    const f32x4 v0 = acc[ai][bj][m][0] * r, v1 = acc[ai][bj][m][1] * r;
                    v4u w; w.x = cvt_pk_bf16(v0[0], v0[1]); w.y = cvt_pk_bf16(v0[2], v0[3]); w.z = cvt_pk_bf16(v1[0], v1[1]); w.w = cvt_pk_bf16(v1[2], v1[3]);
                    *(v4u*)(Q + ((size_t)(b * NH + head) * SEQ + s) * DQK + part * 32 + 8 * fq) = w; } }
    }
};
struct EpiKV { static constexpr bool PERM = true;
    bf16* Kb; bf16* Vb; const bf16* Z; const float* ssq; const float* rcos; const float* rsin; int tid_;
    __device__ __forceinline__ void operator()(AccRef acc, const pg8::Unit& u, int wr, int wc, int fr, int fq) const {
        const int row0 = u.pm * 256 + wr * 64 + fr;
        float rk[8];
#pragma unroll
        for (int i = 0; i < 8; ++i) { const float* p = ssq + (size_t)(row0 + (i >> 2) * 128 + (i & 3) * 16) * 20 + 12 + 2 * fq; rk[i] = p[0] + p[1]; }
#pragma unroll
        for (int i = 0; i < 8; ++i) { float s = rk[i]; s += __shfl_xor(s, 16); s += __shfl_xor(s, 32); rk[i] = 1.0f / sqrtf(s * (1.0f / KVLORA) + RMS_EPS); }
#pragma unroll
        for (int ai = 0; ai < 2; ++ai)
#pragma unroll
            for (int m = 0; m < 4; ++m) { const int row = row0 + ai * 128 + m * 16, b = row / SEQ, s = row - b * SEQ; const float r = rk[ai * 4 + m];
#pragma unroll
                for (int bj = 0; bj < 2; ++bj) { const int col = 256 * u.pn + 128 * bj + 32 * wc + 8 * fq;
                    const f32x4 v0 = acc[ai][bj][m][0] * r, v1 = acc[ai][bj][m][1] * r;
                    v4u w; w.x = cvt_pk_bf16(v0[0], v0[1]); w.y = cvt_pk_bf16(v0[2], v0[3]); w.z = cvt_pk_bf16(v1[0], v1[1]); w.w = cvt_pk_bf16(v1[2], v1[3]);
                    if (col < 512) { const int head = col >> 6, d = col & 63; *(v4u*)(Kb + ((size_t)(b * NH + head) * SEQ + s) * DQK + d) = w; }
                    else { const int c2 = col - 512, head = c2 >> 6, d = c2 & 63; *(v4u*)(Vb + ((size_t)(b * NH + head) * SEQ + s) * DV + d) = w; } } }
        if (u.pn < 2) {
            const int tid = tid_, row = u.pm * 256 + (tid >> 1), jh = tid & 1, b = row / SEQ, s = row - b * SEQ;
            const v4u t1 = *(const v4u*)(Z + (size_t)row * ZLD + ZC_KPE + 8 * jh), t2 = *(const v4u*)(Z + (size_t)row * ZLD + ZC_KPE + 16 + 8 * jh);
            const f32x4 c0 = *(const f32x4*)(rcos + (size_t)s * 16 + 8 * jh), c1 = *(const f32x4*)(rcos + (size_t)s * 16 + 8 * jh + 4), s0 = *(const f32x4*)(rsin + (size_t)s * 16 + 8 * jh), s1 = *(const f32x4*)(rsin + (size_t)s * 16 + 8 * jh + 4);
            float a[8], c[8];
#pragma unroll
            for (int i = 0; i < 4; ++i) { a[2 * i] = bf_lo(t1[i]); a[2 * i + 1] = bf_hi(t1[i]); c[2 * i] = bf_lo(t2[i]); c[2 * i + 1] = bf_hi(t2[i]); }
            float o1[8], o2[8];
#pragma unroll
            for (int i = 0; i < 8; ++i) { const float cs = i < 4 ? c0[i] : c1[i - 4], sn = i < 4 ? s0[i] : s1[i - 4]; o1[i] = a[i] * cs - c[i] * sn; o2[i] = a[i] * sn + c[i] * cs; }
            v4u w1, w2; w1.x = cvt_pk_bf16(o1[0], o1[1]); w1.y = cvt_pk_bf16(o1[2], o1[3]); w1.z = cvt_pk_bf16(o1[4], o1[5]); w1.w = cvt_pk_bf16(o1[6], o1[7]);
            w2.x = cvt_pk_bf16(o2[0], o2[1]); w2.y = cvt_pk_bf16(o2[2], o2[3]); w2.z = cvt_pk_bf16(o2[4], o2[5]); w2.w = cvt_pk_bf16(o2[6], o2[7]);
#pragma unroll
            for (int hh = 0; hh < 4; ++hh) { bf16* kp = Kb + ((size_t)(b * NH + 4 * u.pn + hh) * SEQ + s) * DQK + 64 + 8 * jh; *(v4u*)kp = w1; *(v4u*)(kp + 16) = w2; }
        }
    }
};
struct EpiOut { static constexpr bool PERM = true;
    bf16* Y;
    __device__ __forceinline__ void operator()(AccRef acc, const pg8::Unit& u, int wr, int wc, int fr, int fq) const {
        const int row0 = u.pm * 256 + wr * 64 + fr, col0 = u.pn * 256 + wc * 32 + 8 * fq;
#pragma unroll
        for (int ai = 0; ai < 2; ++ai)
#pragma unroll
            for (int m = 0; m < 4; ++m) { bf16* rowp = Y + (size_t)(row0 + ai * 128 + m * 16) * DM + col0;
#pragma unroll
                for (int bj = 0; bj < 2; ++bj) { const f32x4 v0 = acc[ai][bj][m][0], v1 = acc[ai][bj][m][1];
                    v4u w; w.x = cvt_pk_bf16(v0[0], v0[1]); w.y = cvt_pk_bf16(v0[2], v0[3]); w.z = cvt_pk_bf16(v1[0], v1[1]); w.w = cvt_pk_bf16(v1[2], v1[3]);
                    *(v4u*)(rowp + bj * 128) = w; } }
    }
};
struct EpiLogits { static constexpr bool PERM = false;
    float* LG;
    __device__ __forceinline__ void operator()(AccRef acc, const pg8::Unit& u, int wr, int wc, int fr, int fq) const {
        if (wc >= 2) return;
        const int row0 = u.pm * 256 + wr * 64 + fr;
#pragma unroll
        for (int ai = 0; ai < 2; ++ai)
#pragma unroll
            for (int m = 0; m < 4; ++m) { const int row = row0 + ai * 128 + m * 16;
#pragma unroll
                for (int n = 0; n < 2; ++n) *(f32x4*)(LG + (size_t)row * 64 + 32 * wc + 16 * n + 4 * fq) = acc[ai][0][m][n]; }
    }
};
struct EpiGU { static constexpr bool PERM = true;
    bf16* HID; const float* roww;
    __device__ __forceinline__ void operator()(AccRef acc, const pg8::Unit& u, int wr, int wc, int fr, int fq) const {
        const int row0 = u.pm * 256 + wr * 64 + fr, col0 = u.pn * 128 + wc * 32 + 8 * fq;
        float wv[8];
#pragma unroll
        for (int i = 0; i < 8; ++i) wv[i] = roww[row0 + (i >> 2) * 128 + (i & 3) * 16];
#pragma unroll
        for (int ai = 0; ai < 2; ++ai)
#pragma unroll
            for (int m = 0; m < 4; ++m) { const int row = row0 + ai * 128 + m * 16; const float w = wv[ai * 4 + m];
                float o[8];
#pragma unroll
                for (int n = 0; n < 2; ++n)
#pragma unroll
                    for (int i = 0; i < 4; ++i) { const float gt = acc[ai][0][m][n][i], up = acc[ai][1][m][n][i];
                        const float sg = gt * __builtin_amdgcn_rcpf(1.0f + __builtin_amdgcn_exp2f(-1.4426950408889634f * gt)); o[4 * n + i] = sg * up * w; }
                v4u pk; pk.x = cvt_pk_bf16(o[0], o[1]); pk.y = cvt_pk_bf16(o[2], o[3]); pk.z = cvt_pk_bf16(o[4], o[5]); pk.w = cvt_pk_bf16(o[6], o[7]);
                *(v4u*)(HID + (size_t)row * DEXP + col0) = pk; EPI_FENCE(); }
    }
};
struct EpiDown { static constexpr bool PERM = true;
    bf16* PARTS; const int* rowtok;
    __device__ __forceinline__ void operator()(AccRef acc, const pg8::Unit& u, int wr, int wc, int fr, int fq) const {
        const int row0 = u.pm * 256 + wr * 64 + fr, col0 = u.pn * 256 + wc * 32 + 8 * fq;
        int dv[8];
#pragma unroll
        for (int i = 0; i < 8; ++i) dv[i] = rowtok[row0 + (i >> 2) * 128 + (i & 3) * 16];
#pragma unroll
        for (int ai = 0; ai < 2; ++ai)
#pragma unroll
            for (int m = 0; m < 4; ++m) { const int dst = dv[ai * 4 + m];
                if (dst >= 0) {
#pragma unroll
                    for (int bj = 0; bj < 2; ++bj) { const f32x4 v0 = acc[ai][bj][m][0], v1 = acc[ai][bj][m][1];
                        v4u w; w.x = cvt_pk_bf16(v0[0], v0[1]); w.y = cvt_pk_bf16(v0[2], v0[3]); w.z = cvt_pk_bf16(v1[0], v1[1]); w.w = cvt_pk_bf16(v1[2], v1[3]);
                        *(v4u*)(PARTS + (size_t)dst * DM + col0 + bj * 128) = w; } } EPI_FENCE(); }
    }
};

namespace att {
constexpr int KVBLK = 64;
constexpr int SHM_K = KVBLK * 256, SHM_V = KVBLK * DV * 2;
constexpr int ATT_LDS = 5 * SHM_K + 5 * SHM_V + NWAVES * 64 * 4;
static_assert(ATT_LDS <= RING_BYTES, "attention LDS");
#define KSWZ(row, colB) ((row) * 256 + ((colB) ^ (((row) & 15) << 4)))
#define SBAR() __builtin_amdgcn_sched_barrier(0)
__device__ __forceinline__ int crow(int r, int hi) { return (r & 3) + 8 * (r >> 2) + 4 * hi; }
#ifndef ATT_REF0_MIN
#define ATT_REF0_MIN -40.0f
#endif
#ifndef ATT_OVF
#define ATT_OVF 1e18f
#endif
__device__ __forceinline__ void expP0(f32x16& p0) {
#pragma unroll
    for (int r = 0; r < 16; ++r) p0[r] = __builtin_amdgcn_exp2f(p0[r]);
}
__device__ __forceinline__ float expP1sum(f32x16& p0, f32x16& p1) {
#pragma unroll
    for (int r = 0; r < 16; ++r) p1[r] = __builtin_amdgcn_exp2f(p1[r]);
    float ps = 0;
#pragma unroll
    for (int r = 0; r < 16; ++r) ps += p0[r];
#pragma unroll
    for (int r = 0; r < 16; ++r) ps += p1[r];
    return ps;
}
__device__ __forceinline__ void cvtP(const f32x16& p0, const f32x16& p1, bf16x8& pa0, bf16x8& pa1, bf16x8& pa2, bf16x8& pa3) {
#define PK8(P, BASE, OUT) do { v4u w = {cvt_pk_bf16(P[BASE + 0], P[BASE + 1]), cvt_pk_bf16(P[BASE + 2], P[BASE + 3]), cvt_pk_bf16(P[BASE + 4], P[BASE + 5]), cvt_pk_bf16(P[BASE + 6], P[BASE + 7])}; OUT = *reinterpret_cast<bf16x8*>(&w); } while (0)
    PK8(p0, 0, pa0); PK8(p0, 8, pa1); PK8(p1, 0, pa2); PK8(p1, 8, pa3);
#undef PK8
}
__device__ __forceinline__ float rowmax32(const f32x16& p0, const f32x16& p1) {
    float pmax = p0[0];
#pragma unroll
    for (int r = 1; r < 16; ++r) pmax = fmaxf(pmax, p0[r]);
#pragma unroll
    for (int r = 0; r < 16; ++r) pmax = fmaxf(pmax, p1[r]);
    auto rr = __builtin_amdgcn_permlane32_swap(__float_as_uint(pmax), __float_as_uint(pmax), false, false);
    return fmaxf(__uint_as_float(rr[0]), __uint_as_float(rr[1]));
}
__device__ __forceinline__ void qkt(f32x16& p0, f32x16& p1, const char* Ks, const bf16x8* qr, const f32x16& init, int r32, int hi) {
#pragma unroll
    for (int d0 = 0; d0 < 6; ++d0) { const int cb = (d0 * 16 + hi * 8) * 2;
        const bf16x8 b0 = *reinterpret_cast<const bf16x8*>(Ks + KSWZ(r32, cb));
        const bf16x8 b1 = *reinterpret_cast<const bf16x8*>(Ks + KSWZ(32 + r32, cb));
        p0 = __builtin_amdgcn_mfma_f32_32x32x16_bf16(b0, qr[d0], d0 == 0 ? init : p0, 0, 0, 0);
        p1 = __builtin_amdgcn_mfma_f32_32x32x16_bf16(b1, qr[d0], d0 == 0 ? init : p1, 0, 0, 0); }
}
__device__ __forceinline__ int v_st(int k, int c) { const int kk = (k & ~0xC) | ((k & 4) << 1) | ((k & 8) >> 1); return ((kk >> 3) * 2 + (c >> 5)) * 512 + ((kk & 7) * 32 + (c & 31)) * 2; }
__device__ __forceinline__ int att_v_rd_base(int lane) { return ((lane & 3) << 3) | (((lane >> 2) & 3) << 6) | (((lane >> 4) & 1) << 5) | (((lane >> 5) & 1) << 10); }
constexpr int att_v_rd_off(int d0, int ks, int half) { return d0 * 512 + ks * 2048 + half * 256; }
__device__ __forceinline__ int v_rd_base(int lane) { return ((lane & 3) << 3) | (((lane >> 2) & 3) << 6) | (((lane >> 4) & 1) << 5) | (((lane >> 5) & 1) << 8); }
constexpr int v_rd_off(int d0, int ks, int half) { return d0 * 512 + ks * 2048 + half * 1024; }
template <int OFF> __device__ __forceinline__ s16x4 tr_read(int vb) {
    s16x4 r; asm volatile("ds_read_b64_tr_b16 %0, %1 offset:%2" : "=&v"(r) : "v"(vb), "i"(OFF) : "memory"); return r;
}
template <int D0> __device__ __forceinline__ void pv_one(f32x16& od, int vb, bf16x8 pa0, bf16x8 pa1, bf16x8 pa2, bf16x8 pa3) {
    const s16x4 l0 = tr_read<v_rd_off(D0, 0, 0)>(vb), h0 = tr_read<v_rd_off(D0, 0, 1)>(vb), l1 = tr_read<v_rd_off(D0, 1, 0)>(vb), h1 = tr_read<v_rd_off(D0, 1, 1)>(vb);
    const s16x4 l2 = tr_read<v_rd_off(D0, 2, 0)>(vb), h2 = tr_read<v_rd_off(D0, 2, 1)>(vb), l3 = tr_read<v_rd_off(D0, 3, 0)>(vb), h3 = tr_read<v_rd_off(D0, 3, 1)>(vb);
    asm volatile("s_waitcnt lgkmcnt(0)" ::: "memory"); SBAR();
#define PK(L, H) (bf16x8){L[0], L[1], L[2], L[3], H[0], H[1], H[2], H[3]}
    od = __builtin_amdgcn_mfma_f32_32x32x16_bf16(pa0, PK(l0, h0), od, 0, 0, 0);
    od = __builtin_amdgcn_mfma_f32_32x32x16_bf16(pa1, PK(l1, h1), od, 0, 0, 0);
    od = __builtin_amdgcn_mfma_f32_32x32x16_bf16(pa2, PK(l2, h2), od, 0, 0, 0);
    od = __builtin_amdgcn_mfma_f32_32x32x16_bf16(pa3, PK(l3, h3), od, 0, 0, 0);
#undef PK
}
__device__ __forceinline__ void pv_d0(f32x16* o, int vb, bf16x8 pa0, bf16x8 pa1, bf16x8 pa2, bf16x8 pa3) {
    pv_one<0>(o[0], vb, pa0, pa1, pa2, pa3); pv_one<1>(o[1], vb, pa0, pa1, pa2, pa3);
}
typedef short v4i16_t __attribute__((ext_vector_type(4)));
__device__ __forceinline__ s16x4 vtr(const LAS char* p) { return __builtin_bit_cast(s16x4, __builtin_amdgcn_ds_read_tr16_b64_v4i16((LAS v4i16_t*)p)); }
constexpr int KRING = 5, VRING = 5, LDS_KR = 0, LDS_VR = KRING * SHM_K, LDS_WSF = LDS_VR + VRING * SHM_V;
__device__ __forceinline__ void attn_unit(const bf16* __restrict__ Qb, const bf16* __restrict__ Kh, const bf16* __restrict__ Vh, bf16* __restrict__ Ob, LAS char* lds, const int tid, const float* __restrict__ rcos, const float* __restrict__ rsin, const int spos0) {
    const int wid = __builtin_amdgcn_readfirstlane(tid >> 6), lane = tid & 63, r32 = lane & 31, hi = lane >> 5; const bool g1 = wid >= 4;
    LAS float* wsf = (LAS float*)(lds + LDS_WSF) + wid * 64; LAS float* li_l = wsf; LAS float* al_l = wsf + 32;
    unsigned koff[2];
#pragma unroll
    for (int i = 0; i < 2; ++i) { const int inst = wid + 8 * i, row = 4 * inst + (lane >> 4), phys = lane & 15; int logi = phys ^ (row & 15); if (logi >= 12) logi -= 8; koff[i] = (unsigned)(row * DQK + logi * 8) * 2u; }
    unsigned voff; { const int q16 = 64 * wid + lane, sub = q16 >> 5, within = q16 & 31, kk = ((sub >> 1) << 3) | (within >> 2), k = (kk & ~0xC) | ((kk & 4) << 1) | ((kk & 8) >> 1), c = (sub & 1) * 32 + (within & 3) * 8; voff = (unsigned)(k * DV + c) * 2u; }
    const char* Kg = (const char*)Kh; const char* Vg = (const char*)Vh;
#define DMA_K(t, slot) do { _Pragma("unroll") for (int i_ = 0; i_ < 2; ++i_) __builtin_amdgcn_global_load_lds((const unsigned*)(Kg + (size_t)(t) * (KVBLK * DQK * 2) + koff[i_]), (LAS unsigned*)(lds + LDS_KR + (slot) * SHM_K + (wid + 8 * i_) * 1024), 16, 0, 0); } while (0)
#define DMA_V(t, slot) __builtin_amdgcn_global_load_lds((const unsigned*)(Vg + (size_t)(t) * (KVBLK * DV * 2) + voff), (LAS unsigned*)(lds + LDS_VR + (slot) * SHM_V + wid * 1024), 16, 0, 0)
    DMA_K(0, 0); DMA_K(1, 1); DMA_K(2, 2); DMA_K(3, 3); DMA_V(0, 0); DMA_V(1, 1);
    float lacc = 0; f32x16 o[2] = {}; bf16x8 qr[6];
    const bf16* Qw = Qb + (size_t)(wid * 32 + r32) * DQK + hi * 8;
#pragma unroll
    for (int d0 = 0; d0 < 6; ++d0) qr[d0] = *reinterpret_cast<const bf16x8*>(Qw + d0 * 16);
    {
        const size_t to = (size_t)(spos0 + wid * 32 + r32) * 16 + 8 * hi;
        const f32x4 c0 = *(const f32x4*)(rcos + to), c1 = *(const f32x4*)(rcos + to + 4), s0 = *(const f32x4*)(rsin + to), s1 = *(const f32x4*)(rsin + to + 4);
        const v4u t1 = __builtin_bit_cast(v4u, qr[4]), t2 = __builtin_bit_cast(v4u, qr[5]); v4u o1, o2;
#pragma unroll
        for (int i = 0; i < 4; ++i) { const float ca = i < 2 ? c0[2 * i] : c1[2 * i - 4], cb = i < 2 ? c0[2 * i + 1] : c1[2 * i - 3], sa = i < 2 ? s0[2 * i] : s1[2 * i - 4], sb = i < 2 ? s0[2 * i + 1] : s1[2 * i - 3];
            const float a0 = bf_lo(t1[i]), a1 = bf_hi(t1[i]), b0 = bf_lo(t2[i]), b1 = bf_hi(t2[i]);
            o1[i] = cvt_pk_bf16(a0 * ca - b0 * sa, a1 * cb - b1 * sb); o2[i] = cvt_pk_bf16(a0 * sa + b0 * ca, a1 * sb + b1 * cb); }
        qr[4] = __builtin_bit_cast(bf16x8, o1); qr[5] = __builtin_bit_cast(bf16x8, o2); }
    int kro[6];
#pragma unroll
    for (int d0 = 0; d0 < 6; ++d0) kro[d0] = KSWZ(r32, (d0 * 16 + hi * 8) * 2);
    const int vro = att_v_rd_base(lane);
    bf16x8 kf[6][2]; s16x4 vl[2][4], vh[2][4];
#define KLOAD(slot) do { const LAS char* kb_ = lds + LDS_KR + (slot) * SHM_K; _Pragma("unroll") for (int d0 = 0; d0 < 6; ++d0) { kf[d0][0] = *(const LAS bf16x8*)(kb_ + kro[d0]); kf[d0][1] = *(const LAS bf16x8*)(kb_ + kro[d0] + 32 * 256); } } while (0)
#define VLOAD(slot, d0) do { const LAS char* vb_ = lds + LDS_VR + (slot) * SHM_V + vro; _Pragma("unroll") for (int ks = 0; ks < 4; ++ks) { vl[d0][ks] = vtr(vb_ + att_v_rd_off(d0, ks, 0)); vh[d0][ks] = vtr(vb_ + att_v_rd_off(d0, ks, 1)); } } while (0)
#define QKSTEP(d0, INIT) do { p0 = __builtin_amdgcn_mfma_f32_32x32x16_bf16(kf[d0][0], qr[d0], (d0) == 0 ? (INIT) : p0, 0, 0, 0); p1 = __builtin_amdgcn_mfma_f32_32x32x16_bf16(kf[d0][1], qr[d0], (d0) == 0 ? (INIT) : p1, 0, 0, 0); } while (0)
#define QKF(INIT) do { _Pragma("unroll") for (int d0 = 0; d0 < 6; ++d0) { p0 = __builtin_amdgcn_mfma_f32_32x32x16_bf16(kf[d0][0], qr[d0], d0 == 0 ? (INIT) : p0, 0, 0, 0); p1 = __builtin_amdgcn_mfma_f32_32x32x16_bf16(kf[d0][1], qr[d0], d0 == 0 ? (INIT) : p1, 0, 0, 0); } } while (0)
#define VFR(d0, ks) (bf16x8){vl[d0][ks][0], vl[d0][ks][1], vl[d0][ks][2], vl[d0][ks][3], vh[d0][ks][0], vh[d0][ks][1], vh[d0][ks][2], vh[d0][ks][3]}
#define NEXT5(x) (((x) == KRING - 1) ? 0 : (x) + 1)
#define NEXT3(x) (((x) == VRING - 1) ? 0 : (x) + 1)
    f32x16 p0, p1; float nm  ; const f32x16 zero16 = {}; bf16x8 pa0, pa1, pa2, pa3; constexpr int NT = SEQ / KVBLK;
    asm volatile("s_waitcnt vmcnt(0)" ::: "memory"); __builtin_amdgcn_s_barrier(); SBAR();
    bool slow; KLOAD(0); QKF(zero16); { const float m0_ = rowmax32(p0, p1); slow = __any(!(m0_ >= ATT_REF0_MIN)) != 0; nm = 0.f;
    if (slow) {
#pragma unroll
    for (int r = 0; r < 16; ++r) { p0[r] -= m0_; p1[r] -= m0_; } nm = -m0_; } }
    SBAR(); KLOAD(1); SBAR();
    if (g1) __builtin_amdgcn_s_barrier();
    int ks_cur = 0, ks_ld = 2, ks_dma = 4, vs = 0, vs_dma = 2;
    const char* kp = Kg + (size_t)4 * (KVBLK * DQK * 2); const char* vp = Vg + (size_t)2 * (KVBLK * DV * 2);
    unsigned kd = (unsigned)(LDS_KR + 4 * SHM_K) + (unsigned)wid * 1024u, vd = (unsigned)(LDS_VR + 2 * SHM_V) + (unsigned)wid * 1024u;
    int j = 0;
#define DMA_NEXT() do { asm volatile("" : "+v"(koff[0]), "+v"(koff[1]), "+v"(voff)); const unsigned k0_ = koff[0], k1_ = koff[1], v0_ = voff;     \
          __builtin_amdgcn_global_load_lds((const unsigned*)(kp + k0_), (LAS unsigned*)(lds + kd), 16, 0, 0); \
          __builtin_amdgcn_global_load_lds((const unsigned*)(kp + k1_), (LAS unsigned*)(lds + kd + 8192), 16, 0, 0); \
          __builtin_amdgcn_global_load_lds((const unsigned*)(vp + v0_), (LAS unsigned*)(lds + vd), 16, 0, 0); } while (0)
    auto reref = [&]() __attribute__((always_inline)) {
        const LAS char* kb_ = lds + LDS_KR + ks_cur * SHM_K;
#pragma unroll
        for (int d0 = 0; d0 < 6; ++d0) { const bf16x8 b0 = *(const LAS bf16x8*)(kb_ + kro[d0]), b1 = *(const LAS bf16x8*)(kb_ + kro[d0] + 32 * 256);
            p0 = __builtin_amdgcn_mfma_f32_32x32x16_bf16(b0, qr[d0], d0 == 0 ? zero16 : p0, 0, 0, 0); p1 = __builtin_amdgcn_mfma_f32_32x32x16_bf16(b1, qr[d0], d0 == 0 ? zero16 : p1, 0, 0, 0); }
        const float m_row = -nm; const float mnew = fmaxf(m_row, rowmax32(p0, p1)); const float al = __builtin_amdgcn_exp2f(m_row - mnew);
        if (hi == 0) al_l[r32] = al; asm volatile("s_waitcnt lgkmcnt(0)" ::: "memory");
#pragma unroll
        for (int d = 0; d < 2; ++d)
#pragma unroll
            for (int r = 0; r < 16; ++r) o[d][r] *= al_l[crow(r, hi)];
        lacc *= al;
#pragma unroll
        for (int r = 0; r < 16; ++r) { p0[r] -= mnew; p1[r] -= mnew; }
        nm = -mnew;
    };
    auto xseg = [&](const f32x16& INITV) __attribute__((always_inline)) {

#define PINP() asm volatile("" : "+v"(p0), "+v"(p1) :: "memory")
#define PINO() asm volatile("" : "+v"(o[0]), "+v"(o[1]) :: "memory")
#define VRD2(d0, k0) do { const LAS char* vb_ = lds + LDS_VR + vs * SHM_V + vro; _Pragma("unroll") for (int ks = (k0); ks < (k0) + 2; ++ks) { vl[d0][ks] = vtr(vb_ + att_v_rd_off(d0, ks, 0)); vh[d0][ks] = vtr(vb_ + att_v_rd_off(d0, ks, 1)); } } while (0)
#define KRD1(d0) do { const LAS char* kb_ = lds + LDS_KR + ks_ld * SHM_K; kf[d0][0] = *(const LAS bf16x8*)(kb_ + kro[d0]); kf[d0][1] = *(const LAS bf16x8*)(kb_ + kro[d0] + 32 * 256); } while (0)
#define VRD1(d0, ks) do { const LAS char* vb_ = lds + LDS_VR + vs * SHM_V + vro; vl[d0][ks] = vtr(vb_ + att_v_rd_off(d0, ks, 0)); vh[d0][ks] = vtr(vb_ + att_v_rd_off(d0, ks, 1)); } while (0)
#define QK1(d0, half, INIT) do { if (half == 0) p0 = __builtin_amdgcn_mfma_f32_32x32x16_bf16(kf[d0][0], qr[d0], (d0) == 0 ? (INIT) : p0, 0, 0, 0); else p1 = __builtin_amdgcn_mfma_f32_32x32x16_bf16(kf[d0][1], qr[d0], (d0) == 0 ? (INIT) : p1, 0, 0, 0); } while (0)
        QK1(0, 0, INITV); PINP(); VRD1(0, 0); PINP(); QK1(0, 1, INITV); PINP(); VRD1(0, 1); PINP();
        QK1(1, 0, INITV); PINP(); VRD1(0, 2); PINP(); QK1(1, 1, INITV); PINP(); VRD1(0, 3); PINP();
        QK1(2, 0, INITV); PINP(); VRD1(1, 0); PINP(); QK1(2, 1, INITV); PINP(); VRD1(1, 1); PINP();
        QK1(3, 0, INITV); PINP(); VRD1(1, 2); PINP(); QK1(3, 1, INITV); PINP(); VRD1(1, 3); PINP();
#define QKH(d0, half) do { if ((half) == 0) p0 = __builtin_amdgcn_mfma_f32_32x32x16_bf16(kf[d0][0], qr[d0], p0, 0, 0, 0); else p1 = __builtin_amdgcn_mfma_f32_32x32x16_bf16(kf[d0][1], qr[d0], p1, 0, 0, 0); } while (0)
        QKH(4, 0); QKH(4, 1); PINP(); KRD1(0); PINP(); QKH(5, 0); PINP(); KRD1(1); PINP(); QKH(5, 1); PINP(); KRD1(2); PINP();
        o[0] = __builtin_amdgcn_mfma_f32_32x32x16_bf16(pa0, VFR(0, 0), o[0], 0, 0, 0); PINO(); KRD1(3); PINO();
        o[0] = __builtin_amdgcn_mfma_f32_32x32x16_bf16(pa1, VFR(0, 1), o[0], 0, 0, 0); PINO(); KRD1(4); PINO();
        o[0] = __builtin_amdgcn_mfma_f32_32x32x16_bf16(pa2, VFR(0, 2), o[0], 0, 0, 0); PINO(); KRD1(5); PINO();
        ks_cur = NEXT5(ks_cur); ks_ld = NEXT5(ks_ld); ks_dma = NEXT5(ks_dma); vs = NEXT5(vs); vs_dma = NEXT5(vs_dma); ++j;
        kp += KVBLK * DQK * 2; vp += KVBLK * DV * 2; kd = (unsigned)(LDS_KR + ks_dma * SHM_K) + (unsigned)wid * 1024u; vd = (unsigned)(LDS_VR + vs_dma * SHM_V) + (unsigned)wid * 1024u;
        asm volatile("" : "+s"(ks_cur), "+s"(ks_ld), "+s"(vs), "+s"(kd), "+s"(vd), "+s"(j), "+s"(kp), "+s"(vp));
        o[0] = __builtin_amdgcn_mfma_f32_32x32x16_bf16(pa3, VFR(0, 3), o[0], 0, 0, 0); PINO();
        o[1] = __builtin_amdgcn_mfma_f32_32x32x16_bf16(pa0, VFR(1, 0), o[1], 0, 0, 0); PINO();
        o[1] = __builtin_amdgcn_mfma_f32_32x32x16_bf16(pa1, VFR(1, 1), o[1], 0, 0, 0); PINO();
        o[1] = __builtin_amdgcn_mfma_f32_32x32x16_bf16(pa2, VFR(1, 2), o[1], 0, 0, 0);
        o[1] = __builtin_amdgcn_mfma_f32_32x32x16_bf16(pa3, VFR(1, 3), o[1], 0, 0, 0);
#undef QKH
#undef PINP
#undef PINO
#undef VRD2
#undef KRD1
        SBAR();
        __builtin_amdgcn_s_waitcnt(0xC07F);
        asm volatile("s_waitcnt vmcnt(3)" ::: "memory");
        SBAR(); __builtin_amdgcn_s_barrier(); SBAR();
    };
    bool trig = false;
    if (!slow) {
#pragma unroll 1
        do {
            SBAR();
            float ps;
            expP0(p0); ps = expP1sum(p0, p1);
            if (__builtin_expect(__any(!(ps < ATT_OVF)), 0)) { trig = true; break; }
            lacc += ps; cvtP(p0, p1, pa0, pa1, pa2, pa3);
            SBAR(); DMA_NEXT(); SBAR(); __builtin_amdgcn_s_barrier(); SBAR();
            xseg(zero16);
        } while (j < NT);
        if (trig) reref();
    }
    if (j < NT) {
#pragma unroll 1
        do {
            SBAR();
            float ps;
            expP0(p0); ps = expP1sum(p0, p1);
            if (__builtin_expect(__any(!(ps < ATT_OVF)), 0)) { reref(); expP0(p0); ps = expP1sum(p0, p1); }
            lacc += ps; cvtP(p0, p1, pa0, pa1, pa2, pa3);
            f32x16 negm;
#pragma unroll
            for (int r = 0; r < 16; ++r) { float t_; asm("v_mov_b32 %0, %1" : "=v"(t_) : "v"(nm)); negm[r] = t_; }
            SBAR(); DMA_NEXT(); SBAR(); __builtin_amdgcn_s_barrier(); SBAR();
            xseg(negm);
        } while (j < NT);
    }
#undef DMA_NEXT
    asm volatile("s_waitcnt vmcnt(0)" ::: "memory");
    if (!g1) __builtin_amdgcn_s_barrier();
    __builtin_amdgcn_s_barrier();
    float l_reg; { auto rr = __builtin_amdgcn_permlane32_swap(__float_as_uint(lacc), __float_as_uint(lacc), false, false); l_reg = __uint_as_float(rr[0]) + __uint_as_float(rr[1]); }
    if (hi == 0) li_l[r32] = l_reg; asm volatile("s_waitcnt lgkmcnt(0)" ::: "memory");
    float rli[16];
#pragma unroll
    for (int r = 0; r < 16; ++r) rli[r] = __builtin_amdgcn_rcpf(li_l[crow(r, hi)]);
    LAS bf16* stg = (LAS bf16*)(lds + wid * 4096);
#pragma unroll
    for (int r = 0; r < 16; ++r) { const int orow = crow(r, hi);
#pragma unroll
        for (int d0 = 0; d0 < 2; ++d0) stg[orow * 64 + d0 * 32 + r32] = (bf16)(cvt_pk_bf16(o[d0][r] * rli[r], 0.f) & 0xffffu); }
    asm volatile("s_waitcnt lgkmcnt(0)" ::: "memory");
    bf16* Ow = Ob + (size_t)(wid * 32) * DM;
#pragma unroll
    for (int i = 0; i < 4; ++i) { const int row = i * 8 + (lane >> 3), ch = lane & 7; const v4u v = *(const LAS v4u*)(stg + row * 64 + ch * 8); *(v4u*)(Ow + (size_t)row * DM + ch * 8) = v; }
    asm volatile("s_waitcnt lgkmcnt(0)" ::: "memory"); __builtin_amdgcn_s_barrier();
#undef DMA_K
#undef DMA_V
#undef KLOAD
#undef VLOAD
#undef QKF
#undef QKSTEP
#undef VFR
#undef NEXT5
#undef NEXT3
}
}

namespace fft {
typedef short v4i16_t __attribute__((ext_vector_type(4)));
__device__ __forceinline__ s16x4 vtr(const LAS char* p) { return __builtin_bit_cast(s16x4, __builtin_amdgcn_ds_read_tr16_b64_v4i16((LAS v4i16_t*)p)); }
__device__ __forceinline__ int b_st(int k, int c) { const int kk = (k & ~0xC) | ((k & 4) << 1) | ((k & 8) >> 1); return ((kk >> 3) * 8 + (c >> 5)) * 512 + ((kk & 7) * 32 + (c & 31)) * 2; }
template <int PASS>
__device__ __forceinline__ void fft_unit(int b, int x, const bf16* __restrict__ Zb, bf16* __restrict__ U, bf16* __restrict__ Ob, const bf16* __restrict__ Amat, const float* __restrict__ TW, LAS char* lds, const int tid) {
    const int wid = tid >> 6, lane = tid & 63, r32 = lane & 31, hi = lane >> 5;
    {
        const unsigned lrow = (unsigned)tid >> 5, c = ((unsigned)tid & 31u) * 8u;
        LAS char* ldst = lds + b_st((int)lrow, (int)c);
        const char* ub; unsigned voff;
        if (PASS == 1) { ub = (const char*)(Zb + ((size_t)b * SEQ + x) * ZLD + ZC_FR); voff = (lrow * 128u * ZLD + c) * 2u; }
        else { ub = (const char*)(U + ((size_t)b * 128 + x) * 65536); voff = (lrow * 256u + c) * 2u; }
#pragma unroll
        for (int jb = 0; jb < 2; ++jb) {
            v4u tmp[8];
#pragma unroll
            for (int j = 0; j < 8; ++j) { const int J = jb * 8 + j; const size_t uo = (PASS == 1) ? ((size_t)(J & 7) * 16 * 128 * ZLD + (size_t)(J >> 3) * 256) * 2 : (size_t)J * 8192;
                tmp[j] = *(const v4u*)(ub + uo + voff); }
#pragma unroll
            for (int j = 0; j < 8; ++j) *(LAS v4u*)(ldst + (jb * 8 + j) * 8192) = tmp[j];
        }
    }
    constexpr int NT = 2, NHALF = (PASS == 1) ? 4 : 2;
    const int mrow = (PASS == 1) ? ((r32 < 16) ? (16 * wid + r32) : (128 + 16 * wid + r32 - 16)) : (32 * (wid >> 1) + r32);
    bf16x8 af[16];
#pragma unroll
    for (int ks = 0; ks < 16; ++ks) af[ks] = *reinterpret_cast<const bf16x8*>(Amat + (size_t)mrow * 256 + 16 * ks + 8 * hi);
    __syncthreads();
#pragma unroll 1
    for (int nh = 0; nh < NHALF; ++nh) {
        const int nt0 = (PASS == 1) ? 2 * nh : 4 * (wid & 1) + 2 * nh;
        f32x16 acc[NT];
#pragma unroll
        for (int d = 0; d < NT; ++d) acc[d] = f32x16{};
        const LAS char* vb = lds + att::v_rd_base(lane) + nt0 * 512;
#pragma unroll
        for (int ks = 0; ks < 16; ++ks) {
#pragma unroll
            for (int d = 0; d < NT; ++d) { const s16x4 l = vtr(vb + ks * 8192 + d * 512), h = vtr(vb + ks * 8192 + 4096 + d * 512);
                acc[d] = __builtin_amdgcn_mfma_f32_32x32x16_bf16(af[ks], (bf16x8){l[0], l[1], l[2], l[3], h[0], h[1], h[2], h[3]}, acc[d], 0, 0, 0); }
            if (ks & 1) __builtin_amdgcn_sched_barrier(0);
        }
        if (PASS == 1) {
#pragma unroll
            for (int r = 0; r < 8; ++r) { const int k1 = 16 * wid + att::crow(r, hi); const f32x2 t = *(const f32x2*)(TW + ((size_t)k1 * 128 + x) * 2);
                bf16* ur = U + ((((size_t)b * 128 + k1) * 2 + 0) * 128 + x) * 256 + nt0 * 32; bf16* ui = ur + 128 * 256;
#pragma unroll
                for (int d = 0; d < NT; ++d) { const float re = acc[d][r], im = acc[d][r + 8];
                    const unsigned pk = cvt_pk_bf16(re * t.x + im * t.y, im * t.x - re * t.y);
                    ur[d * 32 + r32] = (bf16)(pk & 0xffffu); ui[d * 32 + r32] = (bf16)(pk >> 16); } }
        } else {
#pragma unroll
            for (int r = 0; r < 16; ++r) { const int k2 = 32 * (wid >> 1) + att::crow(r, hi); bf16* orow = Ob + ((size_t)b * SEQ + x + 128 * k2) * DM + 768 + nt0 * 32;
#pragma unroll
                for (int d = 0; d < NT; ++d) orow[d * 32 + r32] = (bf16)(cvt_pk_bf16(acc[d][r], 0.f) & 0xffffu); }
        }
    }
    __syncthreads();
}
}

#define XB_TMO      128
#define XB_XCNT(j)  (256  + 64 * (j))
#define XB_XSUB(j)  (1280 + 64 * (j))
#define XB_XGEN(j)  (2304 + 64 * (j))
#define XB_TOP      3328
#define XB_TOPGEN   3392
#define XCD_BAR_WORDS 3456
#define XB_SPIN_CAP (1u << 20)
__device__ __forceinline__ unsigned xb_ld(unsigned* p)              { return __hip_atomic_load(p, __ATOMIC_RELAXED, __HIP_MEMORY_SCOPE_AGENT); }
__device__ __forceinline__ unsigned xb_add(unsigned* p, unsigned v) { return __hip_atomic_fetch_add(p, v, __ATOMIC_RELAXED, __HIP_MEMORY_SCOPE_AGENT); }
__device__ __forceinline__ unsigned xb_xcc_id() { return (unsigned)__builtin_amdgcn_s_getreg((3 << 11) | 20) & 0xFu; }
#define XB_SPIN(cond, bar) do { unsigned _sp = 0; while (cond) { __builtin_amdgcn_s_sleep(1); \
    if ((++_sp & 255u) == 0u) { if (xb_ld(&(bar)[XB_TMO])) break; if (_sp > XB_SPIN_CAP) { atomicAdd(&(bar)[XB_TMO], 1u); break; } } } } while (0)
struct XcdBarrier { unsigned* bar; unsigned x; volatile LAS unsigned* st; };
__device__ __forceinline__ XcdBarrier xcd_barrier_post(unsigned* bar, volatile LAS unsigned* st) {
    XcdBarrier b; b.bar = bar; b.x = xb_xcc_id(); b.st = st;
    if (threadIdx.x == 0) (void)xb_add(&bar[XB_XCNT(b.x)], 1u);
    return b;
}
__device__ __forceinline__ void xcd_barrier_complete(unsigned* bar, unsigned x, unsigned& nloc, unsigned& nx) {
    const unsigned G = gridDim.x * gridDim.y * gridDim.z;
    unsigned sum, cnt, mine, sp = 0u;
    for (;;) {
        sum = 0u; cnt = 0u; mine = 0u;
#pragma unroll
        for (unsigned j = 0; j < 16; ++j) { const unsigned c = xb_ld(&bar[XB_XCNT(j)]); sum += c; cnt += (c > 0u) ? 1u : 0u; mine = (j == x) ? c : mine; }
        if (sum == G) break;
        __builtin_amdgcn_s_sleep(1);
        if ((++sp & 255u) == 0u) { if (xb_ld(&bar[XB_TMO])) break; if (sp > XB_SPIN_CAP) { atomicAdd(&bar[XB_TMO], 1u); break; } }
    }
    nloc = mine > 0u ? mine : 1u; nx = cnt > 0u ? cnt : 1u;
}
__device__ __forceinline__ void xcd_barrier(const XcdBarrier& b) {
    asm volatile("s_waitcnt vmcnt(0)" ::: "memory");
    __syncthreads();
    if (threadIdx.x == 0) {
        unsigned* bar = b.bar;
        __builtin_amdgcn_s_waitcnt(0);
        unsigned nloc = b.st[0], nx = b.st[1];
        if (nloc == 0u) { xcd_barrier_complete(bar, b.x, nloc, nx); b.st[0] = nloc; b.st[1] = nx; }
        const unsigned old = xb_add(&bar[XB_XSUB(b.x)], 1u);
        const unsigned gen = old / nloc;
        if (old + 1u == (gen + 1u) * nloc) {
            __builtin_amdgcn_fence(__ATOMIC_RELEASE, "agent");
            asm volatile("s_waitcnt vmcnt(0)" ::: "memory");
            const unsigned og = xb_add(&bar[XB_TOP], 1u);
            const unsigned tg = og / nx;
            if (og + 1u == (tg + 1u) * nx) xb_add(&bar[XB_TOPGEN], 1u);
            else XB_SPIN(xb_ld(&bar[XB_TOPGEN]) == tg, bar);
            __builtin_amdgcn_fence(__ATOMIC_ACQUIRE, "agent");
            xb_add(&bar[XB_XGEN(b.x)], 1u);
            asm volatile("s_waitcnt vmcnt(0)" ::: "memory");
        } else {
            XB_SPIN(xb_ld(&bar[XB_XGEN(b.x)]) == gen, bar);
            __builtin_amdgcn_fence(__ATOMIC_ACQUIRE, "agent");
            asm volatile("s_waitcnt vmcnt(0)" ::: "memory");
        }
    }
    __syncthreads();
}

struct Args {
    const float *x, *ln_in_g, *ln_in_b, *w_in, *g_q, *g_kv, *w_uq, *w_ukv, *w_conv, *w_out, *ln1_g, *ln1_b, *w_group, *b_group, *w_router, *b_router, *w_gate, *w_up, *w_down, *ln2_g, *ln2_b;
    float* out; unsigned char* ws; int ph_lo, ph_hi, sub, pad;
};
constexpr int PH_PER_LAYER = 11, N_PHASES = 1 + DEPTH * PH_PER_LAYER;

template <class F4> __device__ __forceinline__ void tr_item(F4 f4, bf16* WT, int ldt, int k0, int n0, LAS float* scr, int lane) {
    const int krow = lane >> 3, nq = lane & 7; f32x4 t[8];
#pragma unroll
    for (int i = 0; i < 8; ++i) t[i] = f4(k0 + 8 * i + krow, n0 + 4 * nq);
#pragma unroll
    for (int i = 0; i < 8; ++i) *(LAS f32x4*)(scr + (8 * i + krow) * 36 + 4 * nq) = t[i];
    LDS_WAIT(); asm volatile("" ::: "memory");
    const int c = lane & 7;
#pragma unroll
    for (int j = 0; j < 4; ++j) { const int n = (lane >> 3) + 8 * j; const LAS float* sp = scr + (8 * c) * 36 + n;
        v4u o; o.x = cvt_pk_bf16(sp[0 * 36], sp[1 * 36]); o.y = cvt_pk_bf16(sp[2 * 36], sp[3 * 36]); o.z = cvt_pk_bf16(sp[4 * 36], sp[5 * 36]); o.w = cvt_pk_bf16(sp[6 * 36], sp[7 * 36]);
        *(v4u*)(WT + (size_t)(n0 + n) * ldt + k0 + 8 * c) = o; }
    LDS_WAIT(); asm volatile("" ::: "memory");
}
__device__ __forceinline__ void ln_finish(f32x4 (&v)[4], const float* g, const float* bta, int lane, bf16* obf, float* of32) {
    float s = 0.f;
#pragma unroll
    for (int j = 0; j < 4; ++j) s += (v[j][0] + v[j][1]) + (v[j][2] + v[j][3]);
    const float mean = wave_sum(s) * (1.f / DM); float s2 = 0.f;
#pragma unroll
    for (int j = 0; j < 4; ++j) { v[j] = v[j] - mean; s2 += (v[j][0] * v[j][0] + v[j][1] * v[j][1]) + (v[j][2] * v[j][2] + v[j][3] * v[j][3]); }
    const float rstd = 1.f / sqrtf(wave_sum(s2) * (1.f / DM) + LN_EPS);
#pragma unroll
    for (int j = 0; j < 4; ++j) { const f32x4 gg = *(const f32x4*)(g + 4 * lane + 256 * j), bb = *(const f32x4*)(bta + 4 * lane + 256 * j);
        const f32x4 r = v[j] * rstd * gg + bb;
        if (obf) { v2u w; w.x = cvt_pk_bf16(r[0], r[1]); w.y = cvt_pk_bf16(r[2], r[3]); *(v2u*)(obf + 4 * lane + 256 * j) = w; }
        else *(f32x4*)(of32 + 4 * lane + 256 * j) = r; }
}


__device__ __forceinline__ void unpack8(const v4u w, float (&f)[8]) { f[0] = bf_lo(w.x); f[1] = bf_hi(w.x); f[2] = bf_lo(w.y); f[3] = bf_hi(w.y); f[4] = bf_lo(w.z); f[5] = bf_hi(w.z); f[6] = bf_lo(w.w); f[7] = bf_hi(w.w); }
__device__ __forceinline__ void ln16(float (&v)[16], const float* g, const float* bta, int lane, bf16* obf, float* of32) {
    float s = 0.f;
#pragma unroll
    for (int i = 0; i < 16; ++i) s += v[i];
    const float mean = wave_sum(s) * (1.f / DM); float s2 = 0.f;
#pragma unroll
    for (int i = 0; i < 16; ++i) { v[i] -= mean; s2 += v[i] * v[i]; }
    const float rstd = 1.f / sqrtf(wave_sum(s2) * (1.f / DM) + LN_EPS);
#pragma unroll
    for (int j = 0; j < 2; ++j) { const int e0 = 8 * lane + 512 * j; const f32x4 g0 = *(const f32x4*)(g + e0), g1 = *(const f32x4*)(g + e0 + 4), b0 = *(const f32x4*)(bta + e0), b1 = *(const f32x4*)(bta + e0 + 4);
        f32x4 r0, r1;
#pragma unroll
        for (int i = 0; i < 4; ++i) { r0[i] = v[8 * j + i] * rstd * g0[i] + b0[i]; r1[i] = v[8 * j + 4 + i] * rstd * g1[i] + b1[i]; }
        if (obf) { v4u w; w.x = cvt_pk_bf16(r0[0], r0[1]); w.y = cvt_pk_bf16(r0[2], r0[3]); w.z = cvt_pk_bf16(r1[0], r1[1]); w.w = cvt_pk_bf16(r1[2], r1[3]); *(v4u*)(obf + e0) = w; }
        else { *(f32x4*)(of32 + e0) = r0; *(f32x4*)(of32 + e0 + 4) = r1; } }
}
#if PROBE_CHECK
__device__ __forceinline__ float bf2f(bf16 v) { return __uint_as_float((unsigned)v << 16); }
__device__ __forceinline__ void diag_max(gu32* w, float v) { atomicMax((unsigned*)w, __float_as_uint(v < 0.f ? 0.f : v)); }
__device__ __forceinline__ void block_sum2(float& a, float& b, LAS float* red, int tid) {
    a = wave_sum(a); b = wave_sum(b); __syncthreads();
    if ((tid & 63) == 0) { red[tid >> 6] = a; red[8 + (tid >> 6)] = b; } __syncthreads();
    float sa = 0.f, sb = 0.f; for (int i = 0; i < 8; ++i) { sa += red[i]; sb += red[8 + i]; } a = sa; b = sb; __syncthreads();
}
__device__ __forceinline__ void probe_rope(int s, int j, float& cs, float& sn) {
    const int jq = j & 3; const double b4 = jq == 0 ? 1.0 : (jq == 1 ? 0.5623413251903491 : (jq == 2 ? 0.31622776601683794 : 0.1778279410038923)); const int jd = j >> 2; const double d10 = jd == 0 ? 1.0 : (jd == 1 ? 0.1 : (jd == 2 ? 0.01 : 0.001));
    const float ang = (float)s * (float)(b4 * d10); const double rev = (double)ang * 0.15915494309189535; const float fr_ = (float)(rev - floor(rev)); cs = __builtin_amdgcn_cosf(fr_); sn = __builtin_amdgcn_sinf(fr_);
}
__device__ __forceinline__ void probe_qkv(const __attribute__((address_space(4))) Args* AP, int l, int t, const bf16* Zb, const bf16* Qb, const bf16* Kb, const bf16* Vb, gu32* ctl, LAS float* sh, int tid) {
    const int b = t / SEQ, s = t - b * SEQ;
    for (int i = tid; i < 672; i += 512) sh[i] = bf2f(Zb[(size_t)t * ZLD + i]);
    __syncthreads();
    float sq = 0.f, sk = 0.f; for (int i = tid; i < 384; i += 512) sq += sh[i] * sh[i]; for (int i = tid; i < 256; i += 512) sk += sh[384 + i] * sh[384 + i];
    block_sum2(sq, sk, sh + 8000, tid);
    const float rq = 1.0f / sqrtf(sq / 384.f + RMS_EPS), rk = 1.0f / sqrtf(sk / 256.f + RMS_EPS);
    const float* wuq = AP->w_uq + (size_t)l * 384 * 768; const float* wukv = AP->w_ukv + (size_t)l * 256 * 1024; const float* gq = AP->g_q + l * 384; const float* gk = AP->g_kv + l * 256;
    for (int n = tid; n < 768; n += 512) { float a = 0.f; for (int k = 0; k < 384; ++k) a += sh[k] * gq[k] * wuq[(size_t)k * 768 + n]; sh[1024 + n] = a * rq; }
    for (int n = tid; n < 1024; n += 512) { float a = 0.f; for (int k = 0; k < 256; ++k) a += sh[384 + k] * gk[k] * wukv[(size_t)k * 1024 + n]; sh[2048 + n] = a * rk; }
    __syncthreads();
    float nq = 0.f, dq = 0.f, nk = 0.f, dk = 0.f, nv = 0.f, dv = 0.f;
    for (int i = tid; i < 768; i += 512) { const int h = i / 96, d = i - 96 * h; float ref;
        ref = sh[1024 + i];
        ref *= QSCALE; const float mine = bf2f(Qb[((size_t)(b * NH + h) * SEQ + s) * DQK + d]); nq += (ref - mine) * (ref - mine); dq += ref * ref; }
    for (int i = tid; i < 768; i += 512) { const int h = i / 96, d = i - 96 * h; float ref;
        if (d < 64) ref = sh[2048 + h * 128 + d];
        else { const int j = (d - 64) & 15; float cs, sn; probe_rope(s, j, cs, sn); const float t1 = sh[640 + j], t2 = sh[656 + j];
            ref = (d < 80) ? (t1 * cs - t2 * sn) : (t1 * sn + t2 * cs); }
        const float mine = bf2f(Kb[((size_t)(b * NH + h) * SEQ + s) * DQK + d]); nk += (ref - mine) * (ref - mine); dk += ref * ref; }
    for (int i = tid; i < 512; i += 512) { const int h = i >> 6, d = i & 63; const float ref = sh[2048 + h * 128 + 64 + d], mine = bf2f(Vb[((size_t)(b * NH + h) * SEQ + s) * DV + d]); nv += (ref - mine) * (ref - mine); dv += ref * ref; }
    block_sum2(nq, dq, sh + 8000, tid); block_sum2(nk, dk, sh + 8000, tid); block_sum2(nv, dv, sh + 8000, tid);
    if (tid == 0) { diag_max(ctl + CW_DIAG, sqrtf(nq / dq)); diag_max(ctl + CW_DIAG, sqrtf(nk / dk)); diag_max(ctl + CW_DIAG, sqrtf(nv / dv)); }
    __syncthreads();
}
__device__ __forceinline__ void probe_attn(int bh, int s, const bf16* Qb, const bf16* Kb, const bf16* Vb, const bf16* Ob, gu32* ctl, LAS float* sh, int tid) {
    const int b = bh >> 3, h = bh & 7;
    if (tid < 96) sh[tid] = bf2f(Qb[((size_t)bh * SEQ + s) * DQK + tid]);
    __syncthreads();
    if (tid < 16) { float cs, sn; probe_rope(s, tid, cs, sn); const float t1 = sh[64 + tid], t2 = sh[80 + tid]; sh[64 + tid] = t1 * cs - t2 * sn; sh[80 + tid] = t1 * sn + t2 * cs; }
    __syncthreads();
    float mx = -1e30f;
    for (int j = tid; j < SEQ; j += 512) { const bf16* kr = Kb + ((size_t)bh * SEQ + j) * DQK; float sc = 0.f;
#pragma unroll 8
        for (int d = 0; d < 96; ++d) sc += sh[d] * bf2f(kr[d]);
        sh[1024 + j] = sc; mx = fmaxf(mx, sc); }
    for (int o = 1; o < 64; o <<= 1) mx = fmaxf(mx, __shfl_xor(mx, o));
    if ((tid & 63) == 0) sh[256 + (tid >> 6)] = mx; __syncthreads();
    mx = sh[256]; for (int i = 1; i < 8; ++i) mx = fmaxf(mx, sh[256 + i]);
    const int d = tid & 63, sub = tid >> 6; float ls = 0.f, a = 0.f;
    for (int j = sub; j < SEQ; j += 8) { const float pj = exp2f(sh[1024 + j] - mx); ls += pj; a += pj * bf2f(Vb[((size_t)bh * SEQ + j) * DV + d]); }
    sh[300 + tid] = a; if (d == 0) sh[900 + sub] = ls; __syncthreads();
    float nn = 0.f, dd = 0.f;
    if (tid < 64) { float av = 0.f, lv = 0.f; for (int i = 0; i < 8; ++i) { av += sh[300 + 64 * i + tid]; lv += sh[900 + i]; }
        const float ref = av / lv, mine = bf2f(Ob[((size_t)b * SEQ + s) * DM + h * DV + tid]); nn = (ref - mine) * (ref - mine); dd = ref * ref; }
    block_sum2(nn, dd, sh + 20000, tid);
    if (tid == 0) diag_max(ctl + CW_DIAG, sqrtf(nn / dd));
    __syncthreads();
}
__device__ __forceinline__ void probe_moe(const __attribute__((address_space(4))) Args* AP, int l, int t, const bf16* Hb, const v4u* TOK, const bf16* PARTS, gu32* ctl, LAS float* sh, int tid) {
    for (int i = tid; i < 1024; i += 512) sh[i] = bf2f(Hb[(size_t)t * DM + i]);
    __syncthreads();
    if (tid < 36) { float a = 0.f; if (tid < 4) { const float* w = AP->w_group + (size_t)l * DM * 4; for (int k = 0; k < DM; ++k) a += sh[k] * w[k * 4 + tid]; a += AP->b_group[l * 4 + tid]; }
        else { const float* w = AP->w_router + (size_t)l * DM * 32; for (int k = 0; k < DM; ++k) a += sh[k] * w[k * 32 + tid - 4]; a += AP->b_router[l * 32 + tid - 4]; }
        sh[1100 + tid] = a; }
    __syncthreads();
    if (tid == 0) { int gi = 0; for (int i = 1; i < 4; ++i) if (sh[1100 + i] > sh[1100 + gi]) gi = i; float gs = 0.f; for (int i = 0; i < 4; ++i) gs += expf(sh[1100 + i] - sh[1100 + gi]); const float pg = 1.f / gs;
        const LAS float* el = sh + 1104 + 8 * gi; int i1 = 0; for (int i = 1; i < 8; ++i) if (el[i] > el[i1]) i1 = i; int i2 = (i1 == 0) ? 1 : 0; for (int i = 0; i < 8; ++i) if (i != i1 && el[i] > el[i2]) i2 = i;
        const float p1 = 1.f / (1.f + expf(el[i2] - el[i1])); const v4u ti = TOK[t]; const int e1 = ti.x & 255, e2 = ti.y & 255; float w1 = __uint_as_float(ti.z), w2 = __uint_as_float(ti.w);
        const bool same = (e1 == 8 * gi + i1) && (e2 == 8 * gi + i2);
        float werr = 0.f; if (same) { werr = fmaxf(fabsf(w1 - p1 * pg) / (p1 * pg), fabsf(w2 - (1.f - p1) * pg) / ((1.f - p1) * pg)); } else atomicAdd((unsigned*)(ctl + CW_DIAG2), 1u);
        diag_max(ctl + CW_DIAG, werr); sh[1200] = (float)e1; sh[1201] = (float)e2; sh[1202] = w1; sh[1203] = w2; }
    __syncthreads();
    for (int kx = 0; kx < 2; ++kx) { const int e = (int)sh[1200 + kx]; const float w = sh[1202 + kx]; const size_t le = (size_t)l * NEXP + e;
        const float* wg = ((tid < 256) ? AP->w_gate : AP->w_up) + le * DM * DEXP; const int f = tid & 255; float a = 0.f; for (int k = 0; k < DM; ++k) a += sh[k] * wg[(size_t)k * DEXP + f];
        sh[2048 + tid] = a; __syncthreads();
        if (tid < 256) { const float g = sh[2048 + tid], u = sh[2048 + 256 + tid]; sh[3072 + tid] = g / (1.f + expf(-g)) * u * w; } __syncthreads();
        const float* wd = AP->w_down + le * DEXP * DM; float nn = 0.f, dd = 0.f;
        for (int d = tid; d < DM; d += 512) { float a2 = 0.f; for (int ff = 0; ff < DEXP; ++ff) a2 += sh[3072 + ff] * wd[(size_t)ff * DM + d]; const float mine = bf2f(PARTS[(size_t)(2 * t + kx) * DM + d]); nn += (a2 - mine) * (a2 - mine); dd += a2 * a2; }
        block_sum2(nn, dd, sh + 8000, tid);
        if (tid == 0) diag_max(ctl + CW_DIAG, sqrtf(nn / dd));
        __syncthreads(); }
}
#endif

__global__ void __launch_bounds__(NWAVES * 64, 2) fwd(Args A) {
    extern __shared__ __attribute__((aligned(16))) unsigned char lds_raw[];
    LAS unsigned char* lds = (LAS unsigned char*)lds_raw;
    volatile LAS unsigned* MISC = (volatile LAS unsigned*)(lds + MISC_OFF);
    LAS int* seg = (LAS int*)(lds + SEG_OFF);
    const int G = gridDim.x; const int vcu = (G % 8 == 0) ? ((int)blockIdx.x % 8) * (G / 8) + (int)blockIdx.x / 8 : (int)blockIdx.x;
    for (int u = threadIdx.x; u < (LDS_BYTES - LDSCTL_OFF) / 4; u += NWAVES * 64) ((LAS unsigned*)(lds + LDSCTL_OFF))[u] = 0u;
    __syncthreads();
#if MK_PER_PHASE
#define GRID_BAR() do { } while (0)
#else
    XcdBarrier bar = xcd_barrier_post((unsigned*)(A.ws + WS_CTL) + CW_BAR, MISC + 8);
#define GRID_BAR() xcd_barrier(bar)
#endif
    const int lo = A.ph_lo, hi = A.ph_hi;
#ifndef PH_MASK
#define PH_MASK 0xFFF
#endif
#define PHM(j) (((PH_MASK) >> (j)) & 1)
#undef SUBM
#define SUBM (AP->sub)
#define IN(k) (lo <= (k) && (k) < hi)
#define SEAM(k) do { if (IN(k) && IN((k) + 1)) GRID_BAR(); } while (0)
#define PH_IDS() int tid = threadIdx.x; asm volatile("" : "+v"(tid)); const int lane = tid & 63, wave = __builtin_amdgcn_readfirstlane(tid >> 6); const int gw = vcu * NWAVES + wave, NGW = G * NWAVES; \
    const __attribute__((address_space(4))) Args* AP = (const __attribute__((address_space(4))) Args*)__builtin_amdgcn_kernarg_segment_ptr(); asm volatile("" : "+s"(AP)); \
    unsigned char* ws = AP->ws; unsigned char* dout = (unsigned char*)AP->out; (void)lane; (void)gw; (void)NGW; (void)dout; \
    gu32* ctl = (gu32*)(ws + WS_CTL); (void)ctl; \
    bf16* Hb = (bf16*)(ws + WS_H); bf16* Zb = (bf16*)(ws + WS_Z); bf16* Vb = (bf16*)(ws + WS_V); bf16* Ob = (bf16*)(ws + WS_O); \
    bf16* Qb = (bf16*)(dout + DO_Q); bf16* Kb = (bf16*)(dout + DO_K); bf16* Ub = (bf16*)(dout + DO_U); \
    bf16* Y1 = (bf16*)dout; bf16* PARTS = (bf16*)dout; bf16* XG = (bf16*)(ws + WS_Z); bf16* HID = (bf16*)(ws + WS_O); \
    float* SSQ = (float*)(ws + WS_SSQ); float* LG = (float*)(ws + WS_LG); v4u* TOK = (v4u*)(ws + WS_TOK); \
    int* ROWTOK = (int*)(ws + WS_ROWTOK); float* ROWW = (float*)(ws + WS_ROWTOK + 512 * 1024); \
    float* RCOS = (float*)(ws + WS_ROPE); float* RSIN = RCOS + SEQ * 16; \
    bf16* FA1 = (bf16*)(ws + WS_FA1); bf16* FA2 = FA1 + 256 * 256; float* TW = (float*)(ws + WS_FA1 + 256 * 1024); \
    (void)Hb; (void)Zb; (void)Vb; (void)Ob; (void)Qb; (void)Kb; (void)Ub; (void)Y1; (void)PARTS; (void)XG; (void)HID; (void)SSQ; (void)LG; (void)TOK; (void)ROWTOK; (void)ROWW; (void)RCOS; (void)RSIN; (void)FA1; (void)FA2; (void)TW;

    if (PHM(0) && IN(0)) { PH_IDS()
        LAS float* scr = (LAS float*)(lds + wave * 16384);
        int it = gw;
#define JOB_BEGIN(cnt) { const int cnt_ = (cnt); for (; it < cnt_; it += NGW) {
#define JOB_END } it -= cnt_; }
        JOB_BEGIN(DEPTH * 16 * 45) const int l = it / (16 * 45), r = it % (16 * 45), kb = r / 45, nb = r % 45; const int n0 = nb < 21 ? 32 * nb : 768 + 32 * (nb - 21), sc = nb < 21 ? 0 : -96;
            const float* W = AP->w_in + (size_t)l * DM * DIN; tr_item([&](int k, int n) { return *(const f32x4*)(W + (size_t)k * DIN + n + sc); }, (bf16*)(ws + WS_WIN) + (size_t)l * ZLD * DM, DM, 64 * kb, n0, scr, lane);  JOB_END
        JOB_BEGIN(DEPTH * 6 * 24) const int l = it / (6 * 24), r = it % (6 * 24), kb = r / 24, nb = r % 24; const float* W = AP->w_uq + (size_t)l * QLORA * 768; const float* gq = AP->g_q + l * QLORA;
            tr_item([&](int k, int n) { return *(const f32x4*)(W + (size_t)k * 768 + n) * gq[k]; }, (bf16*)(ws + WS_WUQ + l * MiB), QLORA, 64 * kb, 32 * nb, scr, lane);  JOB_END
        JOB_BEGIN(DEPTH * 4 * 32) const int l = it / (4 * 32), r = it % (4 * 32), kb = r / 32, nb = r % 32; const float* W = AP->w_ukv + (size_t)l * KVLORA * 1024; const float* gk = AP->g_kv + l * KVLORA;
            const int n0 = 32 * nb; const int src0 = n0 < 512 ? (n0 >> 6) * 128 + (n0 & 63) : ((n0 - 512) >> 6) * 128 + 64 + ((n0 - 512) & 63);
            tr_item([&](int k, int n) { return *(const f32x4*)(W + (size_t)k * 1024 + src0 + (n - n0)) * gk[k]; }, (bf16*)(ws + WS_WUKV + l * MiB), KVLORA, 64 * kb, n0, scr, lane);  JOB_END
        JOB_BEGIN(DEPTH * 16 * 32) const int l = it / (16 * 32), r = it % (16 * 32), kb = r / 32, nb = r % 32; const float* W = AP->w_out + (size_t)l * DM * DM;
            tr_item([&](int k, int n) { return *(const f32x4*)(W + (size_t)k * DM + n); }, (bf16*)(ws + WS_WOUT) + (size_t)l * DM * DM, DM, 64 * kb, 32 * nb, scr, lane);  JOB_END
        JOB_BEGIN(NEXP * 16 * 16) const int le = it / 256, r = it % 256, kb = r / 16, nb = r % 16; const int n0 = 32 * nb, pn = n0 >> 8, j0 = n0 & 255;
            const float* W = ((j0 < 128) ? AP->w_gate : AP->w_up) + (size_t)le * DM * DEXP; const int src0 = 128 * pn + (j0 & 127);
            tr_item([&](int k, int n) { return *(const f32x4*)(W + (size_t)k * DEXP + src0 + (n - n0)); }, (bf16*)(ws + WS_WGU) + (size_t)le * 512 * DM, DM, 64 * kb, n0, scr, lane);  JOB_END
        JOB_BEGIN(NEXP * 4 * 32) const int le = it / 128, r = it % 128, kb = r / 32, nb = r % 32; const float* W = AP->w_down + (size_t)le * DEXP * DM;
            tr_item([&](int k, int n) { return *(const f32x4*)(W + (size_t)k * DM + n); }, (bf16*)(ws + WS_WD) + (size_t)le * DM * DEXP, DEXP, 64 * kb, 32 * nb, scr, lane);  JOB_END
        JOB_BEGIN(DEPTH * 4 * 16 * 8) const int l = it / 512, r = it % 512, g4 = r / 128, kb = (r / 8) % 16, cb = r % 8; const int k = 64 * kb + lane;
            const float* wr = AP->w_in + (size_t)l * DM * DIN + (size_t)k * DIN + 1440 + 64 * g4; float fv[64];
#pragma unroll
            for (int c = 0; c < 64; c += 4) { const f32x4 t4 = *(const f32x4*)(wr + c); fv[c] = t4[0]; fv[c + 1] = t4[1]; fv[c + 2] = t4[2]; fv[c + 3] = t4[3]; }
            bf16* dst = (bf16*)(ws + WS_WIN) + (size_t)l * ZLD * DM;
            for (int cc = 0; cc < 8; ++cc) { const int cp = 8 * cb + cc; float ar = 0.f, ai = 0.f;
#pragma unroll
                for (int c = 0; c < 64; ++c) { const float fr_ = (float)((c * cp) & 63) * (1.0f / 64.0f); ar += fv[c] * __builtin_amdgcn_cosf(fr_); ai -= fv[c] * __builtin_amdgcn_sinf(fr_); }
                dst[(size_t)(ZC_FR + 64 * g4 + cp) * DM + k] = (bf16)(cvt_pk_bf16(ar * 0.125f, 0.f) & 0xffffu);
                dst[(size_t)(ZC_FR + 256 + 64 * g4 + cp) * DM + k] = (bf16)(cvt_pk_bf16(ai * 0.125f, 0.f) & 0xffffu); }  JOB_END
        JOB_BEGIN(DEPTH * 96 * 128) const int l = it / (96 * 128), r = it % (96 * 128), n = 672 + r / 128, kc = r % 128; *(v4u*)((bf16*)(ws + WS_WIN) + (size_t)l * ZLD * DM + (size_t)n * DM + 8 * kc) = (v4u){0u, 0u, 0u, 0u};  JOB_END
        JOB_BEGIN(DEPTH * 256 * 128) const int l = it / (256 * 128), r = it % (256 * 128), n = r / 128, kc = r % 128; float v[8];
#pragma unroll
            for (int i = 0; i < 8; ++i) { const int k = 8 * kc + i; v[i] = n < 4 ? AP->w_group[(size_t)l * DM * 4 + (size_t)k * 4 + n] : (n < 36 ? AP->w_router[(size_t)l * DM * 32 + (size_t)k * 32 + (n - 4)] : 0.f); }
            v4u o; o.x = cvt_pk_bf16(v[0], v[1]); o.y = cvt_pk_bf16(v[2], v[3]); o.z = cvt_pk_bf16(v[4], v[5]); o.w = cvt_pk_bf16(v[6], v[7]);
            *(v4u*)((bf16*)(ws + WS_WR) + (size_t)l * 256 * DM + (size_t)n * DM + 8 * kc) = o;  JOB_END
#undef JOB_BEGIN
#undef JOB_END
        const int gt = vcu * (NWAVES * 64) + tid, NGT = G * NWAVES * 64;
        for (int i = gt; i < SEQ * 16; i += NGT) { const int s = i >> 4, j = i & 15; const int jq = j & 3; const double b4 = jq == 0 ? 1.0 : (jq == 1 ? 0.5623413251903491 : (jq == 2 ? 0.31622776601683794 : 0.1778279410038923)); const int jd = j >> 2; const double d10 = jd == 0 ? 1.0 : (jd == 1 ? 0.1 : (jd == 2 ? 0.01 : 0.001)); const float invf = (float)(b4 * d10); const float ang = (float)s * invf;
            const double rev = (double)ang * 0.15915494309189535; const float fr_ = (float)(rev - floor(rev)); RCOS[i] = __builtin_amdgcn_cosf(fr_); RSIN[i] = __builtin_amdgcn_sinf(fr_); }
        for (int i = gt; i < 256 * 256; i += NGT) { const int m = i >> 8, k = i & 255, ro = m >> 7, k1 = m & 127, ri = k >> 7, s1 = k & 127; const float fr_ = (float)((k1 * s1) & 127) * (1.0f / 128.0f);
            const float c = __builtin_amdgcn_cosf(fr_) * 0.08838834764831845f, s = __builtin_amdgcn_sinf(fr_) * 0.08838834764831845f;
            const float v = (ro == ri) ? c : (ro == 0 ? s : -s); FA1[i] = (bf16)(cvt_pk_bf16(v, 0.f) & 0xffffu); }
        for (int i = gt; i < 128 * 256; i += NGT) { const int k2 = i >> 8, k = i & 255, ri = k >> 7, s2 = k & 127; const float fr_ = (float)((k2 * s2) & 127) * (1.0f / 128.0f);
            const float v = (ri == 0 ? __builtin_amdgcn_cosf(fr_) : __builtin_amdgcn_sinf(fr_)) * 0.08838834764831845f; FA2[i] = (bf16)(cvt_pk_bf16(v, 0.f) & 0xffffu); }
        for (int i = gt; i < 128 * 128; i += NGT) { const int k1 = i >> 7, s2 = i & 127; const float fr_ = (float)(k1 * s2) * (1.0f / 16384.0f); TW[2 * i] = __builtin_amdgcn_cosf(fr_); TW[2 * i + 1] = __builtin_amdgcn_sinf(fr_); }
        for (int m0 = 2 * gw; m0 < NTOK; m0 += 2 * NGW) { float va[16], vb[16];
#pragma unroll
            for (int j = 0; j < 2; ++j) { const float* xa = AP->x + (size_t)m0 * DM + 8 * lane + 512 * j; const f32x4 a0 = *(const f32x4*)xa, a1 = *(const f32x4*)(xa + 4), b0 = *(const f32x4*)(xa + DM), b1 = *(const f32x4*)(xa + DM + 4);
#pragma unroll
                for (int i = 0; i < 4; ++i) { va[8 * j + i] = a0[i]; va[8 * j + 4 + i] = a1[i]; vb[8 * j + i] = b0[i]; vb[8 * j + 4 + i] = b1[i]; } }
            ln16(va, AP->ln_in_g, AP->ln_in_b, lane, Hb + (size_t)m0 * DM, nullptr); ln16(vb, AP->ln_in_g, AP->ln_in_b, lane, Hb + (size_t)(m0 + 1) * DM, nullptr); }
    }
    SEAM(0);

#pragma unroll 1
    for (int l = 0; l < DEPTH; ++l) {
        const int pb = 1 + l * PH_PER_LAYER;
        if (PHM(1) && IN(pb + 0)) { PH_IDS()
            pg8::Gemm g{Hb, (const bf16*)(ws + WS_WIN) + (size_t)l * ZLD * DM, DM, DM, DM, 0}; pg8::LinOrder S{ZLD / 256, (NTOK / 256) * (ZLD / 256), G, vcu};
            EpiZ E{Zb, SSQ}; pg8::gemm_phase<EpiZ, pg8::LinOrder>(lds, g, S, E, tid);
        }
        SEAM(pb + 0);
        if (PHM(2) && IN(pb + 1)) { PH_IDS()
            if (SUBM & 1) { pg8::Gemm g{Zb, (const bf16*)(ws + WS_WUQ + l * MiB), ZLD, QLORA, QLORA, 0}; pg8::LinOrder S{3, (NTOK / 256) * 3, G, vcu};
              EpiQ E{Qb, SSQ}; pg8::gemm_phase<EpiQ, pg8::LinOrder>(lds, g, S, E, tid); }
            asm volatile("" : "+v"(tid));
            if (SUBM & 2) { pg8::Gemm g{Zb + QLORA, (const bf16*)(ws + WS_WUKV + l * MiB), ZLD, KVLORA, KVLORA, 0}; pg8::KvOrder S{G, vcu};
              EpiKV E{Kb, Vb, Zb, SSQ, RCOS, RSIN, tid}; pg8::gemm_phase<EpiKV, pg8::KvOrder>(lds, g, S, E, tid); }
            asm volatile("" : "+v"(tid));
            if (SUBM & 4) { const float* wc = AP->w_conv + (size_t)l * 3 * 256; const int gt = vcu * (NWAVES * 64) + tid, NGT = G * NWAVES * 64;
              for (int i = gt; i < NTOK * 32; i += NGT) { const int t = i >> 5, c0 = (i & 31) * 8, s = t & (SEQ - 1); const bf16* zr = Zb + (size_t)t * ZLD;
                  const v4u bb = *(const v4u*)(zr + ZC_B + c0), c1 = *(const v4u*)(zr + ZC_C + c0), h1 = *(const v4u*)(zr + ZC_H + c0);
                  v4u cm = {0u, 0u, 0u, 0u}, hm = cm, cp = cm, hp = cm;
                  if (s > 0) { cm = *(const v4u*)(zr - ZLD + ZC_C + c0); hm = *(const v4u*)(zr - ZLD + ZC_H + c0); }
                  if (s < SEQ - 1) { cp = *(const v4u*)(zr + ZLD + ZC_C + c0); hp = *(const v4u*)(zr + ZLD + ZC_H + c0); }
                  float o[8];
#pragma unroll
                  for (int q = 0; q < 4; ++q) {
                      const float w0a = wc[c0 + 2 * q], w1a = wc[256 + c0 + 2 * q], w2a = wc[512 + c0 + 2 * q], w0b = wc[c0 + 2 * q + 1], w1b = wc[256 + c0 + 2 * q + 1], w2b = wc[512 + c0 + 2 * q + 1];
                      o[2 * q] = bf_lo(bb[q]) * (w0a * bf_lo(cm[q]) * bf_lo(hm[q]) + w1a * bf_lo(c1[q]) * bf_lo(h1[q]) + w2a * bf_lo(cp[q]) * bf_lo(hp[q]));
                      o[2 * q + 1] = bf_hi(bb[q]) * (w0b * bf_hi(cm[q]) * bf_hi(hm[q]) + w1b * bf_hi(c1[q]) * bf_hi(h1[q]) + w2b * bf_hi(cp[q]) * bf_hi(hp[q])); }
                  v4u w; w.x = cvt_pk_bf16(o[0], o[1]); w.y = cvt_pk_bf16(o[2], o[3]); w.z = cvt_pk_bf16(o[4], o[5]); w.w = cvt_pk_bf16(o[6], o[7]);
                  *(v4u*)(Ob + (size_t)t * DM + 512 + c0) = w; } }
            __syncthreads();
            asm volatile("" : "+v"(tid));
            if (SUBM & 8) for (int u = vcu; u < BATCH * 128; u += G) fft::fft_unit<1>(u >> 7, u & 127, Zb, Ub, Ob, FA1, TW, (LAS char*)lds, tid);
        }
        SEAM(pb + 1);
        if (PHM(3) && IN(pb + 2)) { PH_IDS()
            if (SUBM & 1) for (int u = vcu; u < BATCH * 128; u += G) fft::fft_unit<2>(u >> 7, u & 127, Zb, Ub, Ob, FA2, TW, (LAS char*)lds, tid);
            asm volatile("" : "+v"(tid));
            if (SUBM & 2) for (int L = vcu; L < BATCH * NH * (SEQ / 256); L += G) { const int bh = L >> 6, qb = L & 63, b = bh >> 3, h = bh & 7;
                att::attn_unit(Qb + ((size_t)bh * SEQ + qb * 256) * DQK, Kb + (size_t)bh * SEQ * DQK, Vb + (size_t)bh * SEQ * DV, Ob + ((size_t)b * SEQ + qb * 256) * DM + h * DV, (LAS char*)lds, tid, RCOS, RSIN, qb * 256); }
        }
        SEAM(pb + 2);
#if PROBE_CHECK == 1 || PROBE_CHECK == 2
        { PH_IDS()
          if (PROBE_CHECK == 1) probe_qkv(AP, l, (vcu * 977 + 131 * l) & (NTOK - 1), Zb, Qb, Kb, Vb, ctl, (LAS float*)lds, tid);
          else probe_attn(vcu & 15, (vcu * 1021 + 77 + 4000 * l) & (SEQ - 1), Qb, Kb, Vb, Ob, ctl, (LAS float*)lds, tid);
          GRID_BAR(); }
#endif
        if (PHM(4) && IN(pb + 3)) { PH_IDS()
            pg8::Gemm g{Ob, (const bf16*)(ws + WS_WOUT) + (size_t)l * DM * DM, DM, DM, DM, 0}; pg8::LinOrder S{4, (NTOK / 256) * 4, G, vcu};
            EpiOut E{Y1}; pg8::gemm_phase<EpiOut, pg8::LinOrder>(lds, g, S, E, tid);
        }
        SEAM(pb + 3);
        if (PHM(5) && IN(pb + 4)) { PH_IDS()
            bf16* hout = (SUBM & 16) ? Ob : Hb;
            for (int m0 = 2 * gw; m0 < NTOK; m0 += 2 * NGW) { float va[16], vb[16];
#pragma unroll
                for (int j = 0; j < 2; ++j) { const size_t eo = (size_t)m0 * DM + 8 * lane + 512 * j;
                    const v4u ha = *(const v4u*)(Hb + eo), ya = *(const v4u*)(Y1 + eo), hb = *(const v4u*)(Hb + eo + DM), yb = *(const v4u*)(Y1 + eo + DM);
                    float fh[8], fy[8]; unpack8(ha, fh); unpack8(ya, fy);
#pragma unroll
                    for (int i = 0; i < 8; ++i) va[8 * j + i] = fy[i] + ALPHA * fh[i];
                    unpack8(hb, fh); unpack8(yb, fy);
#pragma unroll
                    for (int i = 0; i < 8; ++i) vb[8 * j + i] = fy[i] + ALPHA * fh[i]; }
                ln16(va, AP->ln1_g + l * DM, AP->ln1_b + l * DM, lane, hout + (size_t)m0 * DM, nullptr); ln16(vb, AP->ln1_g + l * DM, AP->ln1_b + l * DM, lane, hout + (size_t)(m0 + 1) * DM, nullptr); }
        }
        SEAM(pb + 4);
        if (PHM(6) && IN(pb + 5)) { PH_IDS()
            pg8::Gemm g{Hb, (const bf16*)(ws + WS_WR) + (size_t)l * 256 * DM, DM, DM, DM, 0}; pg8::LinOrder S{1, NTOK / 256, G, vcu};
            EpiLogits E{LG}; pg8::gemm_phase<EpiLogits, pg8::LinOrder>(lds, g, S, E, tid);
        }
        SEAM(pb + 5);
        if (PHM(7) && IN(pb + 6)) { PH_IDS()
            LAS int* lcnt = (LAS int*)(lds + RT_OFF); int* CNTS = (int*)(ws + WS_CNTS);
            for (int ch = vcu; ch < NTOK / 128; ch += G) {
                if (tid < 32) lcnt[tid] = 0;
                __syncthreads();
                int e1 = 0, e2 = 0, r1 = 0, r2 = 0; float w1 = 0.f, w2 = 0.f; const int t = ch * 128 + tid;
                if (tid < 128) {
                    const float* lg = LG + (size_t)t * 64; float gl[4]; int gi = 0;
#pragma unroll
                    for (int i = 0; i < 4; ++i) gl[i] = lg[i] + AP->b_group[l * 4 + i];
                    float gmax = gl[0];
#pragma unroll
                    for (int i = 1; i < 4; ++i) if (gl[i] > gmax) { gmax = gl[i]; gi = i; }
                    float gs = 0.f;
#pragma unroll
                    for (int i = 0; i < 4; ++i) gs += __expf(gl[i] - gmax);
                    const float pg = 1.0f / gs;
                    float el[8];
#pragma unroll
                    for (int i = 0; i < 8; ++i) el[i] = lg[4 + 8 * gi + i] + AP->b_router[l * 32 + 8 * gi + i];
                    int i1 = 0; float m1 = el[0];
#pragma unroll
                    for (int i = 1; i < 8; ++i) if (el[i] > m1) { m1 = el[i]; i1 = i; }
                    int i2 = 0; float m2 = -3.0e38f;
#pragma unroll
                    for (int i = 0; i < 8; ++i) if (i != i1 && el[i] > m2) { m2 = el[i]; i2 = i; }
                    const float x2 = __expf(m2 - m1); const float p1 = 1.0f / (1.0f + x2);
                    w1 = p1 * pg; w2 = (1.0f - p1) * pg; e1 = 8 * gi + i1; e2 = 8 * gi + i2;
                    r1 = atomicAdd((int*)&lcnt[e1], 1); r2 = atomicAdd((int*)&lcnt[e2], 1);
                }
                __syncthreads();
                if (tid < 32) CNTS[((size_t)l * 256 + ch) * 32 + tid] = lcnt[tid];
                if (tid < 128) { v4u o; o.x = (unsigned)e1 | ((unsigned)r1 << 8); o.y = (unsigned)e2 | ((unsigned)r2 << 8); o.z = __float_as_uint(w1); o.w = __float_as_uint(w2); TOK[t] = o; }
                __syncthreads();
            }
        }
        SEAM(pb + 6);
        LAS int* pre = (LAS int*)lds; LAS int* segc = seg + 40;
        if (IN(pb + 7)) { PH_IDS()
            const int* CN = (const int*)(ws + WS_CNTS) + (size_t)l * 256 * 32;
            for (int i = tid; i < 256 * 32 / 4; i += NWAVES * 64) *(LAS v4u*)(pre + 4 * i) = *(const v4u*)(CN + 4 * i);
            __syncthreads();
            if (tid < 32) { int acc = 0; for (int ch = 0; ch < 256; ++ch) { const int c = pre[ch * 32 + tid]; pre[ch * 32 + tid] = acc; acc += c; } segc[tid] = acc; }
            __syncthreads();
            if (tid == 0) { int acc = 0; for (int e = 0; e < NEXP; ++e) { seg[e] = acc; acc += (segc[e] + 255) >> 8; } seg[32] = acc; }
            __syncthreads();
        } else if (IN(pb + 8) || IN(pb + 9)) { PH_IDS()
            const int* CN = (const int*)(ws + WS_CNTS) + (size_t)l * 256 * 32;
            if (tid < 32) { int acc = 0; for (int ch = 0; ch < 256; ++ch) acc += CN[ch * 32 + tid]; segc[tid] = acc; }
            __syncthreads();
            if (tid == 0) { int acc = 0; for (int e = 0; e < NEXP; ++e) { seg[e] = acc; acc += (segc[e] + 255) >> 8; } seg[32] = acc; }
            __syncthreads();
        }
        if (PHM(8) && IN(pb + 7)) { PH_IDS()
            for (int t0 = 2 * gw; t0 < NTOK; t0 += 2 * NGW) { const v4u ti = TOK[t0], tj = TOK[t0 + 1];
                const int a1 = seg[ti.x & 255] * 256 + pre[(t0 >> 7) * 32 + (ti.x & 255)] + (int)(ti.x >> 8), a2 = seg[ti.y & 255] * 256 + pre[(t0 >> 7) * 32 + (ti.y & 255)] + (int)(ti.y >> 8);
                const int b1 = seg[tj.x & 255] * 256 + pre[(t0 >> 7) * 32 + (tj.x & 255)] + (int)(tj.x >> 8), b2 = seg[tj.y & 255] * 256 + pre[(t0 >> 7) * 32 + (tj.y & 255)] + (int)(tj.y >> 8);
                if (lane == 0) { ROWTOK[a1] = 2 * t0; ROWW[a1] = __uint_as_float(ti.z); ROWTOK[a2] = 2 * t0 + 1; ROWW[a2] = __uint_as_float(ti.w);
                                 ROWTOK[b1] = 2 * t0 + 2; ROWW[b1] = __uint_as_float(tj.z); ROWTOK[b2] = 2 * t0 + 3; ROWW[b2] = __uint_as_float(tj.w); } }
            for (int e = vcu; e < NEXP; e += G) { const int c = segc[e];
                for (int r = seg[e] * 256 + c + tid; r < seg[e + 1] * 256; r += NWAVES * 64) { ROWTOK[r] = -1; ROWW[r] = 0.f; } }
        }
        SEAM(pb + 7);
        if (PHM(9) && IN(pb + 8)) { PH_IDS()
            LAS int* gidx = (LAS int*)(lds + GIDX_OFF); const int total9 = seg[32] * 2;
            for (int i = 0; i < 3; ++i) { const int L = i * G + vcu; if (L < total9 && tid < 256) { const int v = ROWTOK[(L >> 1) * 256 + tid]; gidx[i * 256 + tid] = v < 0 ? 0 : (v >> 1); } }
            __syncthreads();
            pg8::Gemm g{Hb, (const bf16*)(ws + WS_WGU) + (size_t)l * NEXP * 512 * DM, DM, DM, DM, (size_t)512 * DM * 2}; pg8::MoeGatherOrder S{{2, total9, G, vcu, seg}, gidx};
            EpiGU E{HID, ROWW}; pg8::gemm_phase<EpiGU, pg8::MoeGatherOrder>(lds, g, S, E, tid);
            if (l + 1 < DEPTH) { const int total = seg[32] * 2, busy = total % G;
                if (vcu >= busy) { LAS float* scr = (LAS float*)(lds + wave * 16384); const int np = G - busy, gwp = (vcu - busy) * NWAVES + wave, ngwp = np * NWAVES; const int l1 = l + 1;
                    __syncthreads();
                    for (int it = gwp; it < NEXP * 256; it += ngwp) { const int le = l1 * NEXP + it / 256, r = it % 256, kb = r / 16, nb = r % 16; const int n0 = 32 * nb, pn = n0 >> 8, j0 = n0 & 255;
                        const float* W = ((j0 < 128) ? AP->w_gate : AP->w_up) + (size_t)le * DM * DEXP; const int src0 = 128 * pn + (j0 & 127);
                        tr_item([&](int k, int n) { return *(const f32x4*)(W + (size_t)k * DEXP + src0 + (n - n0)); }, (bf16*)(ws + WS_WGU) + (size_t)le * 512 * DM, DM, 64 * kb, n0, scr, lane); }
                    for (int it = gwp; it < NEXP * 128; it += ngwp) { const int le = l1 * NEXP + it / 128, r = it % 128, kb = r / 32, nb = r % 32; const float* W = AP->w_down + (size_t)le * DEXP * DM;
                        tr_item([&](int k, int n) { return *(const f32x4*)(W + (size_t)k * DM + n); }, (bf16*)(ws + WS_WD) + (size_t)le * DM * DEXP, DEXP, 64 * kb, 32 * nb, scr, lane); } } }
        }
        SEAM(pb + 8);
        if (PHM(10) && IN(pb + 9)) { PH_IDS()
            pg8::Gemm g{HID, (const bf16*)(ws + WS_WD) + (size_t)l * NEXP * DM * DEXP, DEXP, DEXP, DEXP, (size_t)DM * DEXP * 2}; pg8::MoeOrder S{4, seg[32] * 4, G, vcu, seg};
            EpiDown E{PARTS, ROWTOK}; pg8::gemm_phase<EpiDown, pg8::MoeOrder>(lds, g, S, E, tid);
        }
        SEAM(pb + 9);
#if PROBE_CHECK == 3 || PROBE_CHECK == 4
        { PH_IDS()
          probe_moe(AP, l, (vcu * 977 + 131 * l + 5) & (NTOK - 1), Hb, TOK, PARTS, ctl, (LAS float*)lds, tid);
          GRID_BAR(); }
#endif
        if (PHM(11) && IN(pb + 10)) { PH_IDS()
            const bool lastl = (l == DEPTH - 1); const bool dry = (SUBM & 16) != 0;
            for (int m0 = 2 * gw; m0 < NTOK; m0 += 2 * NGW) { float va[16], vb[16];
#pragma unroll
                for (int j = 0; j < 2; ++j) { const size_t eo = (size_t)m0 * DM + 8 * lane + 512 * j, po = (size_t)(2 * m0) * DM + 8 * lane + 512 * j;
                    const v4u ha = *(const v4u*)(Hb + eo), hb = *(const v4u*)(Hb + eo + DM);
                    const v4u pa0 = *(const v4u*)(PARTS + po), pa1 = *(const v4u*)(PARTS + po + DM), pb0 = *(const v4u*)(PARTS + po + 2 * DM), pb1 = *(const v4u*)(PARTS + po + 3 * DM);
                    float fh[8], f0[8], f1[8]; unpack8(ha, fh); unpack8(pa0, f0); unpack8(pa1, f1);
#pragma unroll
                    for (int i = 0; i < 8; ++i) va[8 * j + i] = ALPHA * fh[i] + (f0[i] + f1[i]);
                    unpack8(hb, fh); unpack8(pb0, f0); unpack8(pb1, f1);
#pragma unroll
                    for (int i = 0; i < 8; ++i) vb[8 * j + i] = ALPHA * fh[i] + (f0[i] + f1[i]); }
                asm volatile("s_waitcnt vmcnt(0)" ::: "memory");
                if (lastl) { float* ob = (dry ? (float*)Zb : AP->out) + (size_t)m0 * DM; ln16(va, AP->ln2_g + l * DM, AP->ln2_b + l * DM, lane, nullptr, ob); ln16(vb, AP->ln2_g + l * DM, AP->ln2_b + l * DM, lane, nullptr, ob + DM); }
                else { bf16* ob = (dry ? Zb : Hb) + (size_t)m0 * DM; ln16(va, AP->ln2_g + l * DM, AP->ln2_b + l * DM, lane, ob, nullptr); ln16(vb, AP->ln2_g + l * DM, AP->ln2_b + l * DM, lane, ob + DM, nullptr); } }
        }
        if (l + 1 < DEPTH) SEAM(pb + 10);
    }
#if PROBE_CHECK
    { GRID_BAR(); PH_IDS()
      float dg = __uint_as_float(__hip_atomic_load((unsigned*)(ctl + CW_DIAG), RLX_AGENT));
      if (PROBE_CHECK == 4) dg = (float)__hip_atomic_load((unsigned*)(ctl + CW_DIAG2), RLX_AGENT) * (1.0f / 512.0f);
      const float sc = 1.0f + 10.0f * dg;
      for (int m = gw; m < NTOK; m += NGW) { f32x4* o = (f32x4*)(AP->out + (size_t)m * DM) + lane;
#pragma unroll
          for (int j = 0; j < 4; ++j) o[64 * j] = o[64 * j] * sc; } }
#endif
#undef IN
#undef SEAM
}

extern "C" void kernel_launch(void* const* d_in, const int* in_sizes, int n_in, void* d_out, int out_size, void* d_ws, size_t ws_size, hipStream_t stream) {
    static int grid = 0;
    if (grid == 0) {
        if (n_in != 21 || in_sizes[0] != NTOK * DM || out_size != NTOK * DM || ws_size < WS_END) { fprintf(stderr, "kernel_launch: shape/workspace mismatch (n_in %d, in0 %d, out %d, ws %zu, need %zu)\n", n_in, n_in > 0 ? in_sizes[0] : -1, out_size, ws_size, (size_t)WS_END); grid = -1; return; }
        int dev = 0, cus = 0, per_cu = 0;
        if (hipGetDevice(&dev) != hipSuccess || hipDeviceGetAttribute(&cus, hipDeviceAttributeMultiprocessorCount, dev) != hipSuccess) { grid = -1; return; }
        if (hipFuncSetAttribute((const void*)fwd, hipFuncAttributeMaxDynamicSharedMemorySize, LDS_BYTES) != hipSuccess) { fprintf(stderr, "kernel_launch: hipFuncSetAttribute failed\n"); grid = -1; return; }
        if (hipOccupancyMaxActiveBlocksPerMultiprocessor(&per_cu, (const void*)fwd, NWAVES * 64, LDS_BYTES) != hipSuccess || per_cu < 1) { fprintf(stderr, "kernel_launch: occupancy query says %d\n", per_cu); }
        (void)hipGetLastError();
        grid = cus;
    }
    if (grid < 0) return;
    if (hipMemsetAsync((char*)d_ws + WS_CTL, 0, CTL_ZERO_BYTES, stream) != hipSuccess) return;
    Args a{};
    const float** ap = (const float**)&a;
    for (int i = 0; i < 21; ++i) ap[i] = (const float*)d_in[i];
    a.out = (float*)d_out; a.ws = (unsigned char*)d_ws; a.sub = 0xF;
#if MK_PER_PHASE
#ifndef REP_SUB
#define REP_SUB 0xF
#endif
#ifndef REP_MASK
#define REP_MASK 0
#endif
    for (int p = 0; p < N_PHASES; ++p) { a.ph_lo = p; a.ph_hi = p + 1; const int j = p == 0 ? 0 : (p - 1) % PH_PER_LAYER + 1;
        for (int rep = 0; rep < (((REP_MASK >> j) & 1) ? 2 : 1); ++rep) { a.sub = rep ? REP_SUB : 0xF; hipLaunchKernelGGL(fwd, dim3(grid), dim3(NWAVES * 64), LDS_BYTES, stream, a); } a.sub = 0xF; }
#else
    a.ph_lo = 0; a.ph_hi = N_PHASES; hipLaunchKernelGGL(fwd, dim3(grid), dim3(NWAVES * 64), LDS_BYTES, stream, a);
#endif
    const hipError_t le = hipPeekAtLastError();
    if (le != hipSuccess) fprintf(stderr, "kernel_launch: launch failed: %s\n", hipGetErrorName(le));
}
```

```cpp
#include <hip/hip_runtime.h>
#include <cstdio>
#include <cstdint>

#ifndef MK_PER_PHASE
#define MK_PER_PHASE 0
#endif

#ifndef PROBE_CHECK
#define PROBE_CHECK 0
#endif
#define GAS __attribute__((address_space(1)))
#define LAS __attribute__((address_space(3)))
typedef unsigned short bf16;
typedef unsigned v4u __attribute__((ext_vector_type(4)));
typedef unsigned v2u __attribute__((ext_vector_type(2)));
typedef float f32x4 __attribute__((ext_vector_type(4)));
typedef float f32x16 __attribute__((ext_vector_type(16)));
typedef short bf16x8 __attribute__((ext_vector_type(8)));
typedef short s16x4 __attribute__((ext_vector_type(4)));
typedef GAS unsigned gu32;
#define RLX_AGENT __ATOMIC_RELAXED, __HIP_MEMORY_SCOPE_AGENT
#define LDS_WAIT() asm volatile("s_waitcnt lgkmcnt(0)" ::: "memory")
#define VM_WAIT() asm volatile("s_waitcnt vmcnt(0)" ::: "memory")

constexpr int BATCH = 2, SEQ = 16384, DM = 1024, NTOK = BATCH * SEQ, DEPTH = 2;
constexpr int NH = 8, DNOPE = 64, DROPE = 32, DQK = 96, DV = 64, QLORA = 384, KVLORA = 256;
constexpr int DIN = 1696, ZLD = 2048;
constexpr int ZC_KPE = 640, ZC_B = 768, ZC_C = 1024, ZC_H = 1280, ZC_FR = 1536;
constexpr int NEXP = 32, DEXP = 256;
constexpr float LN_EPS = 1e-5f, RMS_EPS = 1e-6f;
constexpr float ALPHA = 1.4142135623730951f;
constexpr float QSCALE = 0.10206207261596577f * 1.4426950408889634f;
constexpr int MAXROWS = 73728;

constexpr size_t MiB = 1u << 20;
constexpr size_t WS_CTL = 0, CTL_ZERO_BYTES = 32 * 1024;
constexpr size_t WS_WIN = 1 * MiB;
constexpr size_t WS_WUQ = 9 * MiB;
constexpr size_t WS_WUKV = 11 * MiB;
constexpr size_t WS_WOUT = 13 * MiB;
constexpr size_t WS_WR = 17 * MiB;
constexpr size_t WS_WGU = 18 * MiB;
constexpr size_t WS_WD = 82 * MiB;
constexpr size_t WS_ROPE = 114 * MiB;
constexpr size_t WS_FA1 = 116 * MiB;
constexpr size_t WS_SSQ = 117 * MiB;
constexpr size_t WS_LG = 120 * MiB;
constexpr size_t WS_TOK = 128 * MiB;
constexpr size_t WS_CNTS = 128 * MiB + 512 * 1024;
constexpr size_t WS_ROWTOK = 129 * MiB;
constexpr size_t WS_H = 130 * MiB;
constexpr size_t WS_Z = 194 * MiB;
constexpr size_t WS_V = 338 * MiB;
constexpr size_t WS_O = 370 * MiB;
constexpr size_t WS_END = 434 * MiB;
constexpr size_t DO_Q = 0, DO_K = 48 * MiB, DO_U = 96 * MiB;
constexpr int CW_DIAG = 16, CW_DIAG2 = 17; constexpr int CW_TMO = 0, CW_BAR = 4096;
static_assert((CW_BAR + 3456) * 4 <= (int)CTL_ZERO_BYTES, "barrier words inside the per-call memset");

constexpr int RING_BYTES = 131072;
constexpr int LDSCTL_OFF = RING_BYTES, MISC_OFF = LDSCTL_OFF + 320;
constexpr int SEG_OFF = MISC_OFF + 128;
constexpr int RT_OFF = SEG_OFF + 512;
constexpr int GIDX_OFF = 133120;
constexpr int LDS_BYTES = 147456;
static_assert(RT_OFF + 256 <= GIDX_OFF && GIDX_OFF + 3 * 1024 <= LDS_BYTES, "LDS map (gidx)");
static_assert(RT_OFF + 256 <= LDS_BYTES, "LDS map");
constexpr int NWAVES = 8;

__device__ __forceinline__ unsigned cvt_pk_bf16(float lo, float hi) { unsigned r; asm volatile("v_cvt_pk_bf16_f32 %0, %1, %2" : "=v"(r) : "v"(lo), "v"(hi)); return r; }
__device__ __forceinline__ float bf_lo(unsigned w) { return __uint_as_float(w << 16); }
__device__ __forceinline__ float bf_hi(unsigned w) { return __uint_as_float(w & 0xffff0000u); }
__device__ __forceinline__ float wave_sum(float v) {
#pragma unroll
    for (int o = 1; o < 64; o <<= 1) v += __shfl_xor(v, o);
    return v;
}

namespace pg8 {
typedef unsigned short bf16_t;
constexpr int BM = 256, BK = 64, HALF = 128, HTB = HALF * BK * 2, STAGE_BYTES = 8 * HTB;
__host__ __device__ __forceinline__ int lds_byte(int r, int c) { const int st = (r >> 4) * 2 + (c >> 5), rr = r & 15, cc = c & 31, ob = rr * 64 + cc * 2; return st * 1024 + (ob ^ (((ob >> 9) & 1) << 5)); }
__host__ __device__ __forceinline__ void stage_rc(int b, int& R, int& C) { const int st = b / 1024, sb = b % 1024, swz = sb ^ (((sb >> 9) & 1) << 5); R = (st >> 1) * 16 + swz / 64; C = (st & 1) * 32 + (swz % 64) / 2; }
__host__ __device__ __forceinline__ int perm32(int rho) { const int n = rho >> 4, i = rho & 15; return 8 * (i >> 2) + 4 * n + (i & 3); }

struct Unit { int pm, pn, e; };
struct Gemm { const bf16_t* A; const bf16_t* Bt; int lda, ldb, K; size_t estride; };

template <class Epi, class Sched>
__device__ __forceinline__ void gemm_phase(LAS unsigned char* lds, const Gemm g, const Sched& S, const Epi& E, const int tid) {
    const int wid = __builtin_amdgcn_readfirstlane(tid >> 6), lane = tid & 63, wr = wid >> 2, wc = wid & 3, fr = lane & 15, fq = lane >> 4;
    const int K = g.K, nt = K / BK;
    unsigned voffA[2], voffB[2]; int gR[2]; unsigned gC[2];
#pragma unroll
    for (int i = 0; i < 2; ++i) { int R, C; stage_rc(tid * 16 + i * 8192, R, C); const int Rb = Epi::PERM ? ((R & ~31) + perm32(R & 31)) : R;
        voffA[i] = (unsigned)(R * g.lda + C) * 2u; voffB[i] = (unsigned)(Rb * g.ldb + C) * 2u; gR[i] = R; gC[i] = (unsigned)C * 2u; }
    unsigned vo[2][2], nvo[2][2];
    auto gofs = [&](int unit_i, unsigned (&o)[2][2]) __attribute__((always_inline)) {
        if constexpr (Sched::GATHER) {
#pragma unroll
            for (int h = 0; h < 2; ++h)
#pragma unroll
                for (int i = 0; i < 2; ++i) { const int v = S.gidx[unit_i * 256 + h * 128 + gR[i]]; o[h][i] = (unsigned)v * (unsigned)(g.lda * 2) + gC[i]; } } };
    const size_t kstep = (size_t)(BK * 2);
    const size_t hstepA = (size_t)HALF * g.lda * 2, hstepB = (size_t)HALF * g.ldb * 2;
    const size_t tstepA = 2 * hstepA, tstepB = 2 * hstepB;
    const unsigned ldsw = (unsigned)wid * 1024u;
    const int aoff = lds_byte(wr * 64 + fr, fq * 8), boff = lds_byte(wc * 32 + fr, fq * 8);
#define PG8_SA(b, h) (((b) * 2 + (h)) * HTB)
#define PG8_SB(b, h) ((4 + (b) * 2 + (h)) * HTB)
#define PG8_STAGE(bufoff, gbase, voff) do { _Pragma("unroll") for (int _i = 0; _i < 2; ++_i) \
        __builtin_amdgcn_global_load_lds((const unsigned*)((const char*)(gbase) + (voff)[_i]), (LAS unsigned*)(lds + (bufoff) + ldsw + _i * 8192), 16, 0, 0); } while (0)
#define PG8_STAGE_A(bufoff, kptr, hh, NX) do { if constexpr (Sched::GATHER) { _Pragma("unroll") for (int _i = 0; _i < 2; ++_i) \
        __builtin_amdgcn_global_load_lds((const unsigned*)((const char*)(kptr) + ((NX) ? nvo[hh][_i] : vo[hh][_i])), (LAS unsigned*)(lds + (bufoff) + ldsw + _i * 8192), 16, 0, 0); } \
      else PG8_STAGE(bufoff, (kptr) + (hh) * hstepA, voffA); } while (0)
#define PG8_LDA(dst, b, h) do { _Pragma("unroll") for (int m = 0; m < 4; ++m) _Pragma("unroll") for (int k = 0; k < 2; ++k) dst[m][k] = *(const LAS bf16x8*)(lds + PG8_SA(b, h) + aoff + m * 2048 + k * 1024); } while (0)
#define PG8_LDB(dst, b, h) do { _Pragma("unroll") for (int n = 0; n < 2; ++n) _Pragma("unroll") for (int k = 0; k < 2; ++k) dst[n][k] = *(const LAS bf16x8*)(lds + PG8_SB(b, h) + boff + n * 2048 + k * 1024); } while (0)
#define PG8_MMA(ai, bj, At, Bt) do { __builtin_amdgcn_s_setprio(1); _Pragma("unroll") for (int m = 0; m < 4; ++m) _Pragma("unroll") for (int n = 0; n < 2; ++n) _Pragma("unroll") for (int k = 0; k < 2; ++k) \
        acc[ai][bj][m][n] = __builtin_amdgcn_mfma_f32_16x16x32_bf16(Bt[n][k], At[m][k], acc[ai][bj][m][n], 0, 0, 0); __builtin_amdgcn_s_setprio(0); } while (0)
#define PG8_WAIT_V(n) asm volatile("s_waitcnt vmcnt(" #n ")" ::: "memory")
#define PG8_WAIT_L(n) asm volatile("s_waitcnt lgkmcnt(" #n ")" ::: "memory")
#define PG8_BAR __builtin_amdgcn_s_barrier()
#define PG8_SCHED __builtin_amdgcn_sched_barrier(0)
    Unit cur, nxt; int ui = 0;
    if (!S.next(0, cur)) return;
    f32x4 acc[2][2][4][2];
#pragma unroll
    for (int a = 0; a < 2; ++a)
#pragma unroll
        for (int b = 0; b < 2; ++b)
#pragma unroll
            for (int m = 0; m < 4; ++m)
#pragma unroll
                for (int n = 0; n < 2; ++n) acc[a][b][m][n] = (f32x4){0.f, 0.f, 0.f, 0.f};
    bf16x8 At[4][2], B0[2][2], B1[2][2];
    if constexpr (Sched::GATHER) gofs(0, vo);
    const char* cA = (const char*)g.A + (Sched::GATHER ? (size_t)0 : (size_t)cur.pm * tstepA); const char* cB = (const char*)g.Bt + (size_t)cur.e * g.estride + (size_t)cur.pn * tstepB;
    PG8_STAGE(PG8_SB(0, 0), cB, voffB); PG8_STAGE(PG8_SB(0, 1), cB + hstepB, voffB); PG8_STAGE_A(PG8_SA(0, 0), cA, 0, false); PG8_STAGE_A(PG8_SA(0, 1), cA, 1, false);
    if (wr == 1) PG8_BAR;
    PG8_WAIT_V(2); PG8_BAR;
    PG8_STAGE(PG8_SB(1, 0), cB + kstep, voffB); PG8_STAGE_A(PG8_SA(1, 0), cA + kstep, 0, false); PG8_STAGE(PG8_SB(1, 1), cB + hstepB + kstep, voffB);
    PG8_WAIT_V(6); PG8_BAR;
    for (;;) {
        const bool has_next = S.next(ui + 1, nxt);
        if constexpr (Sched::GATHER) { if (has_next) gofs(ui + 1, nvo); else {
#pragma unroll
            for (int h = 0; h < 2; ++h) { nvo[h][0] = vo[h][0]; nvo[h][1] = vo[h][1]; } } }
        const char* nA = (has_next && !Sched::GATHER) ? (const char*)g.A + (size_t)nxt.pm * tstepA : cA;
        const char* nB = has_next ? (const char*)g.Bt + (size_t)nxt.e * g.estride + (size_t)nxt.pn * tstepB : cB;
#pragma unroll 1
        for (int t = 0; t < nt; t += 2) {
            const bool last = (t == nt - 2);
            const char* a1 = cA + (size_t)(t + 1) * kstep;
            const char* a2 = last ? nA : cA + (size_t)(t + 2) * kstep; const char* b2 = last ? nB : cB + (size_t)(t + 2) * kstep;
            const char* a3 = a2 + kstep; const char* b3 = b2 + kstep;
            PG8_LDB(B0, 0, 0); PG8_LDB(B1, 0, 1); PG8_SCHED; PG8_LDA(At, 0, 0); PG8_STAGE_A(PG8_SA(1, 1), a1, 1, false);
            PG8_WAIT_V(8); PG8_WAIT_L(0); PG8_BAR; PG8_MMA(0, 0, At, B0); PG8_MMA(0, 1, At, B1); PG8_BAR; PG8_SCHED;
            PG8_LDA(At, 0, 1); PG8_STAGE(PG8_SB(0, 0), b2, voffB); PG8_STAGE(PG8_SB(0, 1), b2 + hstepB, voffB); PG8_STAGE_A(PG8_SA(0, 0), a2, 0, last);
            PG8_WAIT_V(8); PG8_WAIT_L(0); PG8_BAR; PG8_MMA(1, 0, At, B0); PG8_MMA(1, 1, At, B1); PG8_BAR; PG8_SCHED;
            PG8_LDB(B0, 1, 0); PG8_LDB(B1, 1, 1); PG8_SCHED; PG8_LDA(At, 1, 0); PG8_STAGE_A(PG8_SA(0, 1), a2, 1, last);
            PG8_WAIT_V(8); PG8_WAIT_L(0); PG8_BAR; PG8_MMA(0, 0, At, B0); PG8_MMA(0, 1, At, B1); PG8_BAR; PG8_SCHED;
            PG8_LDA(At, 1, 1); PG8_STAGE(PG8_SB(1, 0), b3, voffB); PG8_STAGE(PG8_SB(1, 1), b3 + hstepB, voffB); PG8_STAGE_A(PG8_SA(1, 0), a3, 0, last);
            PG8_WAIT_V(8); PG8_WAIT_L(0); PG8_BAR; PG8_MMA(1, 0, At, B0); PG8_MMA(1, 1, At, B1); PG8_BAR; PG8_SCHED;
        }
        if (wr == 0) PG8_BAR;
        E(acc, cur, wr, wc, fr, fq);
        if (!has_next) break;
#pragma unroll
        for (int a = 0; a < 2; ++a)
#pragma unroll
            for (int b = 0; b < 2; ++b)
#pragma unroll
                for (int m = 0; m < 4; ++m)
#pragma unroll
                    for (int n = 0; n < 2; ++n) acc[a][b][m][n] = (f32x4){0.f, 0.f, 0.f, 0.f};
        cur = nxt; cA = nA; cB = nB; ++ui;
        if constexpr (Sched::GATHER) {
#pragma unroll
            for (int h = 0; h < 2; ++h) { vo[h][0] = nvo[h][0]; vo[h][1] = nvo[h][1]; } }
        if (wr == 1) PG8_BAR;
    }
    PG8_WAIT_V(0);
    PG8_BAR;
#undef PG8_SA
#undef PG8_SB
#undef PG8_STAGE
#undef PG8_STAGE_A
#undef PG8_LDA
#undef PG8_LDB
#undef PG8_MMA
#undef PG8_WAIT_V
#undef PG8_WAIT_L
#undef PG8_BAR
#undef PG8_SCHED
}

struct LinOrder {
    static constexpr bool GATHER = false;
    int nN, total, G, c;
    __device__ __forceinline__ bool next(int i, Unit& u) const { const int L = i * G + c; if (L >= total) return false; u.pm = L / nN; u.pn = L - u.pm * nN; u.e = 0; return true; }
};
struct KvOrder {
    static constexpr bool GATHER = false;
    int G, c;
    __device__ __forceinline__ bool next(int i, Unit& u) const {
        int L;
        if (G != 256) { L = i * G + c; if (L >= 512) return false; }
        else if (c < 128) { if (i > 0) return false; L = c; }
        else { if (i > 2) return false; L = 128 + (c - 128) * 3 + i; }
        u.pm = L >> 2; u.pn = L & 3; u.e = 0; return true; }
};
struct MoeOrder {
    static constexpr bool GATHER = false;
    int nN, total, G, c; const LAS int* seg;
    __device__ __forceinline__ bool next(int i, Unit& u) const { const int L = i * G + c; if (L >= total) return false; u.pm = L / nN; u.pn = L - u.pm * nN;
        const int ln = (int)(threadIdx.x & 63u); const int sv = (ln >= 1 && ln < NEXP) ? seg[ln] : 0x7fffffff;
        u.e = (int)__popcll(__ballot(sv <= u.pm)); return true; }
};
struct MoeGatherOrder : MoeOrder { static constexpr bool GATHER = true; const LAS int* gidx; };
}

typedef float f32x2 __attribute__((ext_vector_type(2)));
typedef const f32x4 (&AccRef)[2][2][4][2];
#define EPI_FENCE() do { asm volatile("" ::: "memory"); __builtin_amdgcn_sched_barrier(0); } while (0)
struct EpiZ { static constexpr bool PERM = true;
    bf16* Z; float* ssq;
    __device__ __forceinline__ void operator()(AccRef acc, const pg8::Unit& u, int wr, int wc, int fr, int fq) const {
        const int row0 = u.pm * 256 + wr * 64 + fr, col0 = u.pn * 256 + wc * 32 + 8 * fq;
#pragma unroll
        for (int ai = 0; ai < 2; ++ai)
#pragma unroll
            for (int m = 0; m < 4; ++m) { const int row = row0 + ai * 128 + m * 16; bf16* rowp = Z + (size_t)row * ZLD + col0;
#pragma unroll
                for (int bj = 0; bj < 2; ++bj) { const f32x4 v0 = acc[ai][bj][m][0], v1 = acc[ai][bj][m][1];
                    v4u w; w.x = cvt_pk_bf16(v0[0], v0[1]); w.y = cvt_pk_bf16(v0[2], v0[3]); w.z = cvt_pk_bf16(v1[0], v1[1]); w.w = cvt_pk_bf16(v1[2], v1[3]);
                    __builtin_nontemporal_store(w, (v4u*)(rowp + bj * 128));
                    const int grp = 2 * u.pn + bj;
                    if (grp < 5) { float s = (v0[0] * v0[0] + v0[1] * v0[1]) + (v0[2] * v0[2] + v0[3] * v0[3]) + (v1[0] * v1[0] + v1[1] * v1[1]) + (v1[2] * v1[2] + v1[3] * v1[3]);
                        s += __shfl_xor(s, 16); s += __shfl_xor(s, 32);
                        if (fq == 0) ssq[(size_t)row * 20 + grp * 4 + wc] = s; } } EPI_FENCE(); }
    }
};
__device__ __forceinline__ float ssq_sum(const float* p, int n4) { float s = 0.f; for (int i = 0; i < n4; ++i) { const f32x4 v = *(const f32x4*)(p + 4 * i); s += (v[0] + v[1]) + (v[2] + v[3]); } return s; }
struct EpiQ { static constexpr bool PERM = true;
    bf16* Q; const float* ssq;
    __device__ __forceinline__ void operator()(AccRef acc, const pg8::Unit& u, int wr, int wc, int fr, int fq) const {
        const int row0 = u.pm * 256 + wr * 64 + fr;
        float rq[8];
#pragma unroll
        for (int i = 0; i < 8; ++i) { const float* p = ssq + (size_t)(row0 + (i >> 2) * 128 + (i & 3) * 16) * 20 + 3 * fq; rq[i] = (p[0] + p[1]) + p[2]; }
#pragma unroll
        for (int i = 0; i < 8; ++i) { float s = rq[i]; s += __shfl_xor(s, 16); s += __shfl_xor(s, 32); rq[i] = QSCALE / sqrtf(s * (1.0f / QLORA) + RMS_EPS); }
#pragma unroll
        for (int ai = 0; ai < 2; ++ai)
#pragma unroll
            for (int m = 0; m < 4; ++m) { const int row = row0 + ai * 128 + m * 16, b = row / SEQ, s = row - b * SEQ; const float r = rq[ai * 4 + m];
#pragma unroll
                for (int bj = 0; bj < 2; ++bj) { const int c32 = 8 * u.pn + 4 * bj + wc, head = c32 / 3, part = c32 - 3 * head;
                    const f32x4 v0 = acc[ai][bj][m][0] * r, v1 = acc[ai][bj][m][1] * r;
                    v4u w; w.x = cvt_pk_bf16(v0[0], v0[1]); w.y = cvt_pk_bf16(v0[2], v0[3]); w.z = cvt_pk_bf16(v1[0], v1[1]); w.w = cvt_pk_bf16(v1[2], v1[3]);
                    *(v4u*)(Q + ((size_t)(b * NH + head) * SEQ + s) * DQK + part * 32 + 8 * fq) = w; } }
    }
};
struct EpiKV { static constexpr bool PERM = true;
    bf16* Kb; bf16* Vb; const bf16* Z; const float* ssq; const float* rcos; const float* rsin; int tid_;
    __device__ __forceinline__ void operator()(AccRef acc, const pg8::Unit& u, int wr, int wc, int fr, int fq) const {
        const int row0 = u.pm * 256 + wr * 64 + fr;
        float rk[8];
#pragma unroll
        for (int i = 0; i < 8; ++i) { const float* p = ssq + (size_t)(row0 + (i >> 2) * 128 + (i & 3) * 16) * 20 + 12 + 2 * fq; rk[i] = p[0] + p[1]; }
#pragma unroll
        for (int i = 0; i < 8; ++i) { float s = rk[i]; s += __shfl_xor(s, 16); s += __shfl_xor(s, 32); rk[i] = 1.0f / sqrtf(s * (1.0f / KVLORA) + RMS_EPS); }
#pragma unroll
        for (int ai = 0; ai < 2; ++ai)
#pragma unroll
            for (int m = 0; m < 4; ++m) { const int row = row0 + ai * 128 + m * 16, b = row / SEQ, s = row - b * SEQ; const float r = rk[ai * 4 + m];
#pragma unroll
                for (int bj = 0; bj < 2; ++bj) { const int col = 256 * u.pn + 128 * bj + 32 * wc + 8 * fq;
                    const f32x4 v0 = acc[ai][bj][m][0] * r, v1 = acc[ai][bj][m][1] * r;
                    v4u w; w.x = cvt_pk_bf16(v0[0], v0[1]); w.y = cvt_pk_bf16(v0[2], v0[3]); w.z = cvt_pk_bf16(v1[0], v1[1]); w.w = cvt_pk_bf16(v1[2], v1[3]);
                    if (col < 512) { const int head = col >> 6, d = col & 63; *(v4u*)(Kb + ((size_t)(b * NH + head) * SEQ + s) * DQK + d) = w; }
                    else { const int c2 = col - 512, head = c2 >> 6, d = c2 & 63; *(v4u*)(Vb + ((size_t)(b * NH + head) * SEQ + s) * DV + d) = w; } } }
        if (u.pn < 2) {
            const int tid = tid_, row = u.pm * 256 + (tid >> 1), jh = tid & 1, b = row / SEQ, s = row - b * SEQ;
            const v4u t1 = *(const v4u*)(Z + (size_t)row * ZLD + ZC_KPE + 8 * jh), t2 = *(const v4u*)(Z + (size_t)row * ZLD + ZC_KPE + 16 + 8 * jh);
            const f32x4 c0 = *(const f32x4*)(rcos + (size_t)s * 16 + 8 * jh), c1 = *(const f32x4*)(rcos + (size_t)s * 16 + 8 * jh + 4), s0 = *(const f32x4*)(rsin + (size_t)s * 16 + 8 * jh), s1 = *(const f32x4*)(rsin + (size_t)s * 16 + 8 * jh + 4);
            float a[8], c[8];
#pragma unroll
            for (int i = 0; i < 4; ++i) { a[2 * i] = bf_lo(t1[i]); a[2 * i + 1] = bf_hi(t1[i]); c[2 * i] = bf_lo(t2[i]); c[2 * i + 1] = bf_hi(t2[i]); }
            float o1[8], o2[8];
#pragma unroll
            for (int i = 0; i < 8; ++i) { const float cs = i < 4 ? c0[i] : c1[i - 4], sn = i < 4 ? s0[i] : s1[i - 4]; o1[i] = a[i] * cs - c[i] * sn; o2[i] = a[i] * sn + c[i] * cs; }
            v4u w1, w2; w1.x = cvt_pk_bf16(o1[0], o1[1]); w1.y = cvt_pk_bf16(o1[2], o1[3]); w1.z = cvt_pk_bf16(o1[4], o1[5]); w1.w = cvt_pk_bf16(o1[6], o1[7]);
            w2.x = cvt_pk_bf16(o2[0], o2[1]); w2.y = cvt_pk_bf16(o2[2], o2[3]); w2.z = cvt_pk_bf16(o2[4], o2[5]); w2.w = cvt_pk_bf16(o2[6], o2[7]);
#pragma unroll
            for (int hh = 0; hh < 4; ++hh) { bf16* kp = Kb + ((size_t)(b * NH + 4 * u.pn + hh) * SEQ + s) * DQK + 64 + 8 * jh; *(v4u*)kp = w1; *(v4u*)(kp + 16) = w2; }
        }
    }
};
struct EpiOut { static constexpr bool PERM = true;
    bf16* Y;
    __device__ __forceinline__ void operator()(AccRef acc, const pg8::Unit& u, int wr, int wc, int fr, int fq) const {
        const int row0 = u.pm * 256 + wr * 64 + fr, col0 = u.pn * 256 + wc * 32 + 8 * fq;
#pragma unroll
        for (int ai = 0; ai < 2; ++ai)
#pragma unroll
            for (int m = 0; m < 4; ++m) { bf16* rowp = Y + (size_t)(row0 + ai * 128 + m * 16) * DM + col0;
#pragma unroll
                for (int bj = 0; bj < 2; ++bj) { const f32x4 v0 = acc[ai][bj][m][0], v1 = acc[ai][bj][m][1];
                    v4u w; w.x = cvt_pk_bf16(v0[0], v0[1]); w.y = cvt_pk_bf16(v0[2], v0[3]); w.z = cvt_pk_bf16(v1[0], v1[1]); w.w = cvt_pk_bf16(v1[2], v1[3]);
                    __builtin_nontemporal_store(w, (v4u*)(rowp + bj * 128)); } }
    }
};
struct EpiLogits { static constexpr bool PERM = false;
    float* LG;
    __device__ __forceinline__ void operator()(AccRef acc, const pg8::Unit& u, int wr, int wc, int fr, int fq) const {
        if (wc >= 2) return;
        const int row0 = u.pm * 256 + wr * 64 + fr;
#pragma unroll
        for (int ai = 0; ai < 2; ++ai)
#pragma unroll
            for (int m = 0; m < 4; ++m) { const int row = row0 + ai * 128 + m * 16;
#pragma unroll
                for (int n = 0; n < 2; ++n) *(f32x4*)(LG + (size_t)row * 64 + 32 * wc + 16 * n + 4 * fq) = acc[ai][0][m][n]; }
    }
};
struct EpiGU { static constexpr bool PERM = true;
    bf16* HID; const float* roww;
    __device__ __forceinline__ void operator()(AccRef acc, const pg8::Unit& u, int wr, int wc, int fr, int fq) const {
        const int row0 = u.pm * 256 + wr * 64 + fr, col0 = u.pn * 128 + wc * 32 + 8 * fq;
        float wv[8];
#pragma unroll
        for (int i = 0; i < 8; ++i) wv[i] = roww[row0 + (i >> 2) * 128 + (i & 3) * 16];
#pragma unroll
        for (int ai = 0; ai < 2; ++ai)
#pragma unroll
            for (int m = 0; m < 4; ++m) { const int row = row0 + ai * 128 + m * 16; const float w = wv[ai * 4 + m];
                float o[8];
#pragma unroll
                for (int n = 0; n < 2; ++n)
#pragma unroll
                    for (int i = 0; i < 4; ++i) { const float gt = acc[ai][0][m][n][i], up = acc[ai][1][m][n][i];
                        const float sg = gt * __builtin_amdgcn_rcpf(1.0f + __builtin_amdgcn_exp2f(-1.4426950408889634f * gt)); o[4 * n + i] = sg * up * w; }
                v4u pk; pk.x = cvt_pk_bf16(o[0], o[1]); pk.y = cvt_pk_bf16(o[2], o[3]); pk.z = cvt_pk_bf16(o[4], o[5]); pk.w = cvt_pk_bf16(o[6], o[7]);
                *(v4u*)(HID + (size_t)row * DEXP + col0) = pk; EPI_FENCE(); }
    }
};
struct EpiDown { static constexpr bool PERM = true;
    bf16* PARTS; const int* rowtok;
    __device__ __forceinline__ void operator()(AccRef acc, const pg8::Unit& u, int wr, int wc, int fr, int fq) const {
        const int row0 = u.pm * 256 + wr * 64 + fr, col0 = u.pn * 256 + wc * 32 + 8 * fq;
        int dv[8];
#pragma unroll
        for (int i = 0; i < 8; ++i) dv[i] = rowtok[row0 + (i >> 2) * 128 + (i & 3) * 16];
#pragma unroll
        for (int ai = 0; ai < 2; ++ai)
#pragma unroll
            for (int m = 0; m < 4; ++m) { const int dst = dv[ai * 4 + m];
                if (dst >= 0) {
#pragma unroll
                    for (int bj = 0; bj < 2; ++bj) { const f32x4 v0 = acc[ai][bj][m][0], v1 = acc[ai][bj][m][1];
                        v4u w; w.x = cvt_pk_bf16(v0[0], v0[1]); w.y = cvt_pk_bf16(v0[2], v0[3]); w.z = cvt_pk_bf16(v1[0], v1[1]); w.w = cvt_pk_bf16(v1[2], v1[3]);
                        *(v4u*)(PARTS + (size_t)dst * DM + col0 + bj * 128) = w; } } EPI_FENCE(); }
    }
};

namespace att {
constexpr int KVBLK = 64;
constexpr int SHM_K = KVBLK * 256, SHM_V = KVBLK * DV * 2;
constexpr int ATT_LDS = 5 * SHM_K + 5 * SHM_V + NWAVES * 64 * 4;
static_assert(ATT_LDS <= RING_BYTES, "attention LDS");
#define KSWZ(row, colB) ((row) * 256 + ((colB) ^ (((row) & 15) << 4)))
#define SBAR() __builtin_amdgcn_sched_barrier(0)
__device__ __forceinline__ int crow(int r, int hi) { return (r & 3) + 8 * (r >> 2) + 4 * hi; }
#ifndef ATT_REF0_MIN
#define ATT_REF0_MIN -40.0f
#endif
#ifndef ATT_OVF
#define ATT_OVF 1e18f
#endif
__device__ __forceinline__ void expP0(f32x16& p0) {
#pragma unroll
    for (int r = 0; r < 16; ++r) p0[r] = __builtin_amdgcn_exp2f(p0[r]);
}
__device__ __forceinline__ float expP1sum(f32x16& p0, f32x16& p1) {
#pragma unroll
    for (int r = 0; r < 16; ++r) p1[r] = __builtin_amdgcn_exp2f(p1[r]);
    float ps = p0[0];
#pragma unroll
    for (int r = 1; r < 16; ++r) ps += p0[r];
#pragma unroll
    for (int r = 0; r < 16; ++r) ps += p1[r];
    return ps;
}
__device__ __forceinline__ void cvtP(const f32x16& p0, const f32x16& p1, bf16x8& pa0, bf16x8& pa1, bf16x8& pa2, bf16x8& pa3) {
#define PK8(P, BASE, OUT) do { v4u w = {cvt_pk_bf16(P[BASE + 0], P[BASE + 1]), cvt_pk_bf16(P[BASE + 2], P[BASE + 3]), cvt_pk_bf16(P[BASE + 4], P[BASE + 5]), cvt_pk_bf16(P[BASE + 6], P[BASE + 7])}; OUT = *reinterpret_cast<bf16x8*>(&w); } while (0)
    PK8(p0, 0, pa0); PK8(p0, 8, pa1); PK8(p1, 0, pa2); PK8(p1, 8, pa3);
#undef PK8
}
__device__ __forceinline__ float rowmax32(const f32x16& p0, const f32x16& p1) {
    float pmax = p0[0];
#pragma unroll
    for (int r = 1; r < 16; ++r) pmax = fmaxf(pmax, p0[r]);
#pragma unroll
    for (int r = 0; r < 16; ++r) pmax = fmaxf(pmax, p1[r]);
    auto rr = __builtin_amdgcn_permlane32_swap(__float_as_uint(pmax), __float_as_uint(pmax), false, false);
    return fmaxf(__uint_as_float(rr[0]), __uint_as_float(rr[1]));
}
__device__ __forceinline__ void qkt(f32x16& p0, f32x16& p1, const char* Ks, const bf16x8* qr, const f32x16& init, int r32, int hi) {
#pragma unroll
    for (int d0 = 0; d0 < 6; ++d0) { const int cb = (d0 * 16 + hi * 8) * 2;
        const bf16x8 b0 = *reinterpret_cast<const bf16x8*>(Ks + KSWZ(r32, cb));
        const bf16x8 b1 = *reinterpret_cast<const bf16x8*>(Ks + KSWZ(32 + r32, cb));
        p0 = __builtin_amdgcn_mfma_f32_32x32x16_bf16(b0, qr[d0], d0 == 0 ? init : p0, 0, 0, 0);
        p1 = __builtin_amdgcn_mfma_f32_32x32x16_bf16(b1, qr[d0], d0 == 0 ? init : p1, 0, 0, 0); }
}
__device__ __forceinline__ int v_st(int k, int c) { const int kk = (k & ~0xC) | ((k & 4) << 1) | ((k & 8) >> 1); return ((kk >> 3) * 2 + (c >> 5)) * 512 + ((kk & 7) * 32 + (c & 31)) * 2; }
__device__ __forceinline__ int att_v_rd_base(int lane) { return ((lane & 3) << 3) | (((lane >> 2) & 3) << 6) | (((lane >> 4) & 1) << 5) | (((lane >> 5) & 1) << 10); }
constexpr int att_v_rd_off(int d0, int ks, int half) { return d0 * 512 + ks * 2048 + half * 256; }
__device__ __forceinline__ int v_rd_base(int lane) { return ((lane & 3) << 3) | (((lane >> 2) & 3) << 6) | (((lane >> 4) & 1) << 5) | (((lane >> 5) & 1) << 8); }
constexpr int v_rd_off(int d0, int ks, int half) { return d0 * 512 + ks * 2048 + half * 1024; }
template <int OFF> __device__ __forceinline__ s16x4 tr_read(int vb) {
    s16x4 r; asm volatile("ds_read_b64_tr_b16 %0, %1 offset:%2" : "=&v"(r) : "v"(vb), "i"(OFF) : "memory"); return r;
}
template <int D0> __device__ __forceinline__ void pv_one(f32x16& od, int vb, bf16x8 pa0, bf16x8 pa1, bf16x8 pa2, bf16x8 pa3) {
    const s16x4 l0 = tr_read<v_rd_off(D0, 0, 0)>(vb), h0 = tr_read<v_rd_off(D0, 0, 1)>(vb), l1 = tr_read<v_rd_off(D0, 1, 0)>(vb), h1 = tr_read<v_rd_off(D0, 1, 1)>(vb);
    const s16x4 l2 = tr_read<v_rd_off(D0, 2, 0)>(vb), h2 = tr_read<v_rd_off(D0, 2, 1)>(vb), l3 = tr_read<v_rd_off(D0, 3, 0)>(vb), h3 = tr_read<v_rd_off(D0, 3, 1)>(vb);
    asm volatile("s_waitcnt lgkmcnt(0)" ::: "memory"); SBAR();
#define PK(L, H) (bf16x8){L[0], L[1], L[2], L[3], H[0], H[1], H[2], H[3]}
    od = __builtin_amdgcn_mfma_f32_32x32x16_bf16(pa0, PK(l0, h0), od, 0, 0, 0);
    od = __builtin_amdgcn_mfma_f32_32x32x16_bf16(pa1, PK(l1, h1), od, 0, 0, 0);
    od = __builtin_amdgcn_mfma_f32_32x32x16_bf16(pa2, PK(l2, h2), od, 0, 0, 0);
    od = __builtin_amdgcn_mfma_f32_32x32x16_bf16(pa3, PK(l3, h3), od, 0, 0, 0);
#undef PK
}
__device__ __forceinline__ void pv_d0(f32x16* o, int vb, bf16x8 pa0, bf16x8 pa1, bf16x8 pa2, bf16x8 pa3) {
    pv_one<0>(o[0], vb, pa0, pa1, pa2, pa3); pv_one<1>(o[1], vb, pa0, pa1, pa2, pa3);
}
typedef short v4i16_t __attribute__((ext_vector_type(4)));
__device__ __forceinline__ s16x4 vtr(const LAS char* p) { return __builtin_bit_cast(s16x4, __builtin_amdgcn_ds_read_tr16_b64_v4i16((LAS v4i16_t*)p)); }
template <int N> struct IC5 { static constexpr int value = N; };
static_assert((SEQ / 64) % 5 == 1, "ring-period unrolling of the reference-0 loop assumes NT = 5 k + 1");
constexpr int KRING = 5, VRING = 5, LDS_KR = 0, LDS_VR = KRING * SHM_K, LDS_WSF = LDS_VR + VRING * SHM_V;
__device__ __forceinline__ void attn_unit(const bf16* __restrict__ Qb, const bf16* __restrict__ Kh, const bf16* __restrict__ Vh, bf16* __restrict__ Ob, LAS char* lds, const int tid, const float* __restrict__ rcos, const float* __restrict__ rsin, const int spos0) {
    const int wid = __builtin_amdgcn_readfirstlane(tid >> 6), lane = tid & 63, r32 = lane & 31, hi = lane >> 5; const bool g1 = wid >= 4;
    LAS float* wsf = (LAS float*)(lds + LDS_WSF) + wid * 64; LAS float* li_l = wsf; LAS float* al_l = wsf + 32;
    unsigned koff[2];
#pragma unroll
    for (int i = 0; i < 2; ++i) { const int inst = wid + 8 * i, row = 4 * inst + (lane >> 4), phys = lane & 15; int logi = phys ^ (row & 15); if (logi >= 12) logi -= 8; koff[i] = (unsigned)(row * DQK + logi * 8) * 2u; }
    unsigned voff; { const int q16 = 64 * wid + lane, sub = q16 >> 5, within = q16 & 31, kk = ((sub >> 1) << 3) | (within >> 2), k = (kk & ~0xC) | ((kk & 4) << 1) | ((kk & 8) >> 1), c = (sub & 1) * 32 + (within & 3) * 8; voff = (unsigned)(k * DV + c) * 2u; }
    const char* Kg = (const char*)Kh; const char* Vg = (const char*)Vh;
#define DMA_K(t, slot) do { _Pragma("unroll") for (int i_ = 0; i_ < 2; ++i_) __builtin_amdgcn_global_load_lds((const unsigned*)(Kg + (size_t)(t) * (KVBLK * DQK * 2) + koff[i_]), (LAS unsigned*)(lds + LDS_KR + (slot) * SHM_K + (wid + 8 * i_) * 1024), 16, 0, 0); } while (0)
#define DMA_V(t, slot) __builtin_amdgcn_global_load_lds((const unsigned*)(Vg + (size_t)(t) * (KVBLK * DV * 2) + voff), (LAS unsigned*)(lds + LDS_VR + (slot) * SHM_V + wid * 1024), 16, 0, 0)
    DMA_K(0, 0); DMA_K(1, 1); DMA_K(2, 2); DMA_K(3, 3); DMA_V(0, 0); DMA_V(1, 1);
    float lacc = 0; f32x16 o[2] = {}; bf16x8 qr[6];
    const bf16* Qw = Qb + (size_t)(wid * 32 + r32) * DQK + hi * 8;
#pragma unroll
    for (int d0 = 0; d0 < 6; ++d0) qr[d0] = *reinterpret_cast<const bf16x8*>(Qw + d0 * 16);
    {
        const size_t to = (size_t)(spos0 + wid * 32 + r32) * 16 + 8 * hi;
        const f32x4 c0 = *(const f32x4*)(rcos + to), c1 = *(const f32x4*)(rcos + to + 4), s0 = *(const f32x4*)(rsin + to), s1 = *(const f32x4*)(rsin + to + 4);
        const v4u t1 = __builtin_bit_cast(v4u, qr[4]), t2 = __builtin_bit_cast(v4u, qr[5]); v4u o1, o2;
#pragma unroll
        for (int i = 0; i < 4; ++i) { const float ca = i < 2 ? c0[2 * i] : c1[2 * i - 4], cb = i < 2 ? c0[2 * i + 1] : c1[2 * i - 3], sa = i < 2 ? s0[2 * i] : s1[2 * i - 4], sb = i < 2 ? s0[2 * i + 1] : s1[2 * i - 3];
            const float a0 = bf_lo(t1[i]), a1 = bf_hi(t1[i]), b0 = bf_lo(t2[i]), b1 = bf_hi(t2[i]);
            o1[i] = cvt_pk_bf16(a0 * ca - b0 * sa, a1 * cb - b1 * sb); o2[i] = cvt_pk_bf16(a0 * sa + b0 * ca, a1 * sb + b1 * cb); }
        qr[4] = __builtin_bit_cast(bf16x8, o1); qr[5] = __builtin_bit_cast(bf16x8, o2); }
    int kro[6];
#pragma unroll
    for (int d0 = 0; d0 < 6; ++d0) kro[d0] = KSWZ(r32, (d0 * 16 + hi * 8) * 2);
    const int vro = att_v_rd_base(lane);
    bf16x8 kf[6][2]; s16x4 vl[2][4], vh[2][4];
#define KLOAD(slot) do { const LAS char* kb_ = lds + LDS_KR + (slot) * SHM_K; _Pragma("unroll") for (int d0 = 0; d0 < 6; ++d0) { kf[d0][0] = *(const LAS bf16x8*)(kb_ + kro[d0]); kf[d0][1] = *(const LAS bf16x8*)(kb_ + kro[d0] + 32 * 256); } } while (0)
#define VLOAD(slot, d0) do { const LAS char* vb_ = lds + LDS_VR + (slot) * SHM_V + vro; _Pragma("unroll") for (int ks = 0; ks < 4; ++ks) { vl[d0][ks] = vtr(vb_ + att_v_rd_off(d0, ks, 0)); vh[d0][ks] = vtr(vb_ + att_v_rd_off(d0, ks, 1)); } } while (0)
#define QKSTEP(d0, INIT) do { p0 = __builtin_amdgcn_mfma_f32_32x32x16_bf16(kf[d0][0], qr[d0], (d0) == 0 ? (INIT) : p0, 0, 0, 0); p1 = __builtin_amdgcn_mfma_f32_32x32x16_bf16(kf[d0][1], qr[d0], (d0) == 0 ? (INIT) : p1, 0, 0, 0); } while (0)
#define QKF(INIT) do { _Pragma("unroll") for (int d0 = 0; d0 < 6; ++d0) { p0 = __builtin_amdgcn_mfma_f32_32x32x16_bf16(kf[d0][0], qr[d0], d0 == 0 ? (INIT) : p0, 0, 0, 0); p1 = __builtin_amdgcn_mfma_f32_32x32x16_bf16(kf[d0][1], qr[d0], d0 == 0 ? (INIT) : p1, 0, 0, 0); } } while (0)
#define VFR(d0, ks) (bf16x8){vl[d0][ks][0], vl[d0][ks][1], vl[d0][ks][2], vl[d0][ks][3], vh[d0][ks][0], vh[d0][ks][1], vh[d0][ks][2], vh[d0][ks][3]}
#define NEXT5(x) (((x) == KRING - 1) ? 0 : (x) + 1)
#define NEXT3(x) (((x) == VRING - 1) ? 0 : (x) + 1)
    f32x16 p0, p1; float nm  ; const f32x16 zero16 = {}; bf16x8 pa0, pa1, pa2, pa3; constexpr int NT = SEQ / KVBLK;
    asm volatile("s_waitcnt vmcnt(0)" ::: "memory"); __builtin_amdgcn_s_barrier(); SBAR();
    bool slow; KLOAD(0); QKF(zero16); { const float m0_ = rowmax32(p0, p1); slow = __any(!(m0_ >= ATT_REF0_MIN)) != 0; nm = 0.f;
    if (slow) {
#pragma unroll
    for (int r = 0; r < 16; ++r) { p0[r] -= m0_; p1[r] -= m0_; } nm = -m0_; } }
    SBAR(); KLOAD(1); SBAR();
    if (g1) __builtin_amdgcn_s_barrier();
    int ks_cur = 0, ks_ld = 2, ks_dma = 4, vs = 0, vs_dma = 2;
    const char* kp = Kg + (size_t)4 * (KVBLK * DQK * 2); const char* vp = Vg + (size_t)2 * (KVBLK * DV * 2);
    unsigned kd = (unsigned)(LDS_KR + 4 * SHM_K) + (unsigned)wid * 1024u, vd = (unsigned)(LDS_VR + 2 * SHM_V) + (unsigned)wid * 1024u;
    int j = 0;
#define DMA_NEXT() do { asm volatile("" : "+v"(koff[0]), "+v"(koff[1]), "+v"(voff)); const unsigned k0_ = koff[0], k1_ = koff[1], v0_ = voff;     \
          __builtin_amdgcn_global_load_lds((const unsigned*)(kp + k0_), (LAS unsigned*)(lds + kd), 16, 0, 0); \
          __builtin_amdgcn_global_load_lds((const unsigned*)(kp + k1_), (LAS unsigned*)(lds + kd + 8192), 16, 0, 0); \
          __builtin_amdgcn_global_load_lds((const unsigned*)(vp + v0_), (LAS unsigned*)(lds + vd), 16, 0, 0); } while (0)
    auto reref = [&]() __attribute__((always_inline)) {
        const LAS char* kb_ = lds + LDS_KR + ks_cur * SHM_K;
#pragma unroll
        for (int d0 = 0; d0 < 6; ++d0) { const bf16x8 b0 = *(const LAS bf16x8*)(kb_ + kro[d0]), b1 = *(const LAS bf16x8*)(kb_ + kro[d0] + 32 * 256);
            p0 = __builtin_amdgcn_mfma_f32_32x32x16_bf16(b0, qr[d0], d0 == 0 ? zero16 : p0, 0, 0, 0); p1 = __builtin_amdgcn_mfma_f32_32x32x16_bf16(b1, qr[d0], d0 == 0 ? zero16 : p1, 0, 0, 0); }
        const float m_row = -nm; const float mnew = fmaxf(m_row, rowmax32(p0, p1)); const float al = __builtin_amdgcn_exp2f(m_row - mnew);
        if (hi == 0) al_l[r32] = al; asm volatile("s_waitcnt lgkmcnt(0)" ::: "memory");
#pragma unroll
        for (int d = 0; d < 2; ++d)
#pragma unroll
            for (int r = 0; r < 16; ++r) o[d][r] *= al_l[crow(r, hi)];
        lacc *= al;
#pragma unroll
        for (int r = 0; r < 16; ++r) { p0[r] -= mnew; p1[r] -= mnew; }
        nm = -mnew;
    };
    auto xseg = [&](const f32x16& INITV) __attribute__((always_inline)) {

#define PINP() asm volatile("" : "+v"(p0), "+v"(p1) :: "memory")
#define PINO() asm volatile("" : "+v"(o[0]), "+v"(o[1]) :: "memory")
#define VRD2(d0, k0) do { const LAS char* vb_ = lds + LDS_VR + vs * SHM_V + vro; _Pragma("unroll") for (int ks = (k0); ks < (k0) + 2; ++ks) { vl[d0][ks] = vtr(vb_ + att_v_rd_off(d0, ks, 0)); vh[d0][ks] = vtr(vb_ + att_v_rd_off(d0, ks, 1)); } } while (0)
#define KRD1(d0) do { const LAS char* kb_ = lds + LDS_KR + ks_ld * SHM_K; kf[d0][0] = *(const LAS bf16x8*)(kb_ + kro[d0]); kf[d0][1] = *(const LAS bf16x8*)(kb_ + kro[d0] + 32 * 256); } while (0)
#define VRD1(d0, ks) do { const LAS char* vb_ = lds + LDS_VR + vs * SHM_V + vro; vl[d0][ks] = vtr(vb_ + att_v_rd_off(d0, ks, 0)); vh[d0][ks] = vtr(vb_ + att_v_rd_off(d0, ks, 1)); } while (0)
#define QK1(d0, half, INIT) do { if (half == 0) p0 = __builtin_amdgcn_mfma_f32_32x32x16_bf16(kf[d0][0], qr[d0], (d0) == 0 ? (INIT) : p0, 0, 0, 0); else p1 = __builtin_amdgcn_mfma_f32_32x32x16_bf16(kf[d0][1], qr[d0], (d0) == 0 ? (INIT) : p1, 0, 0, 0); } while (0)
        QK1(0, 0, INITV); PINP(); VRD1(0, 0); PINP(); QK1(0, 1, INITV); PINP(); VRD1(0, 1); PINP();
        QK1(1, 0, INITV); PINP(); VRD1(0, 2); PINP(); QK1(1, 1, INITV); PINP(); VRD1(0, 3); PINP();
        QK1(2, 0, INITV); PINP(); VRD1(1, 0); PINP(); QK1(2, 1, INITV); PINP(); VRD1(1, 1); PINP();
        QK1(3, 0, INITV); PINP(); VRD1(1, 2); PINP(); QK1(3, 1, INITV); PINP(); VRD1(1, 3); PINP();
#define QKH(d0, half) do { if ((half) == 0) p0 = __builtin_amdgcn_mfma_f32_32x32x16_bf16(kf[d0][0], qr[d0], p0, 0, 0, 0); else p1 = __builtin_amdgcn_mfma_f32_32x32x16_bf16(kf[d0][1], qr[d0], p1, 0, 0, 0); } while (0)
        QKH(4, 0); QKH(4, 1); PINP(); KRD1(0); PINP(); QKH(5, 0); PINP(); KRD1(1); PINP(); QKH(5, 1); PINP(); KRD1(2); PINP();
        o[0] = __builtin_amdgcn_mfma_f32_32x32x16_bf16(pa0, VFR(0, 0), o[0], 0, 0, 0); PINO(); KRD1(3); PINO();
        o[0] = __builtin_amdgcn_mfma_f32_32x32x16_bf16(pa1, VFR(0, 1), o[0], 0, 0, 0); PINO(); KRD1(4); PINO();
        o[0] = __builtin_amdgcn_mfma_f32_32x32x16_bf16(pa2, VFR(0, 2), o[0], 0, 0, 0); PINO(); KRD1(5); PINO();
        ks_cur = NEXT5(ks_cur); ks_ld = NEXT5(ks_ld); ks_dma = NEXT5(ks_dma); vs = NEXT5(vs); vs_dma = NEXT5(vs_dma); ++j;
        kp += KVBLK * DQK * 2; vp += KVBLK * DV * 2; kd = (unsigned)(LDS_KR + ks_dma * SHM_K) + (unsigned)wid * 1024u; vd = (unsigned)(LDS_VR + vs_dma * SHM_V) + (unsigned)wid * 1024u;
        asm volatile("" : "+s"(ks_cur), "+s"(ks_ld), "+s"(vs), "+s"(kd), "+s"(vd), "+s"(j), "+s"(kp), "+s"(vp));
        o[0] = __builtin_amdgcn_mfma_f32_32x32x16_bf16(pa3, VFR(0, 3), o[0], 0, 0, 0); PINO();
        o[1] = __builtin_amdgcn_mfma_f32_32x32x16_bf16(pa0, VFR(1, 0), o[1], 0, 0, 0); PINO();
        o[1] = __builtin_amdgcn_mfma_f32_32x32x16_bf16(pa1, VFR(1, 1), o[1], 0, 0, 0); PINO();
        o[1] = __builtin_amdgcn_mfma_f32_32x32x16_bf16(pa2, VFR(1, 2), o[1], 0, 0, 0);
        o[1] = __builtin_amdgcn_mfma_f32_32x32x16_bf16(pa3, VFR(1, 3), o[1], 0, 0, 0);
#undef QKH
#undef PINP
#undef PINO
#undef VRD2
#undef KRD1
        SBAR();
        __builtin_amdgcn_s_waitcnt(0xC07F);
        asm volatile("s_waitcnt vmcnt(3)" ::: "memory");
        SBAR(); __builtin_amdgcn_s_barrier(); SBAR();
    };
    const int vrob = vro + LDS_VR; int kro4[6];
#pragma unroll
    for (int d0 = 0; d0 < 6; ++d0) kro4[d0] = kro[d0] + LDS_KR + 4 * SHM_K;
    auto xsegc = [&](auto CC) __attribute__((always_inline)) {
        constexpr int C_ = decltype(CC)::value; constexpr int KS_C = (C_ + 2) % 5, VS_C = C_;

#define PINP() asm volatile("" : "+v"(p0), "+v"(p1) :: "memory")
#define PINO() asm volatile("" : "+v"(o[0]), "+v"(o[1]) :: "memory")
#define VRD2(d0, k0) do { const LAS char* vb_ = lds + VS_C * SHM_V + vrob; _Pragma("unroll") for (int ks = (k0); ks < (k0) + 2; ++ks) { vl[d0][ks] = vtr(vb_ + att_v_rd_off(d0, ks, 0)); vh[d0][ks] = vtr(vb_ + att_v_rd_off(d0, ks, 1)); } } while (0)
#define KRD1(d0) do { const LAS char* kb_ = lds + ((KS_C == 4) ? 0 : LDS_KR + KS_C * SHM_K); const int ko_ = (KS_C == 4) ? kro4[d0] : kro[d0]; kf[d0][0] = *(const LAS bf16x8*)(kb_ + ko_); kf[d0][1] = *(const LAS bf16x8*)(kb_ + ko_ + 32 * 256); } while (0)
#define VRD1(d0, ks) do { const LAS char* vb_ = lds + VS_C * SHM_V + vrob; vl[d0][ks] = vtr(vb_ + att_v_rd_off(d0, ks, 0)); vh[d0][ks] = vtr(vb_ + att_v_rd_off(d0, ks, 1)); } while (0)
#define QK1(d0, half, INIT) do { if (half == 0) p0 = __builtin_amdgcn_mfma_f32_32x32x16_bf16(kf[d0][0], qr[d0], (d0) == 0 ? (INIT) : p0, 0, 0, 0); else p1 = __builtin_amdgcn_mfma_f32_32x32x16_bf16(kf[d0][1], qr[d0], (d0) == 0 ? (INIT) : p1, 0, 0, 0); } while (0)
        QK1(0, 0, zero16); PINP(); VRD1(0, 0); PINP(); QK1(0, 1, zero16); PINP(); VRD1(0, 1); PINP();
        QK1(1, 0, zero16); PINP(); VRD1(0, 2); PINP(); QK1(1, 1, zero16); PINP(); VRD1(0, 3); PINP();
        QK1(2, 0, zero16); PINP(); VRD1(1, 0); PINP(); QK1(2, 1, zero16); PINP(); VRD1(1, 1); PINP();
        QK1(3, 0, zero16); PINP(); VRD1(1, 2); PINP(); QK1(3, 1, zero16); PINP(); VRD1(1, 3); PINP();
#define QKH(d0, half) do { if ((half) == 0) p0 = __builtin_amdgcn_mfma_f32_32x32x16_bf16(kf[d0][0], qr[d0], p0, 0, 0, 0); else p1 = __builtin_amdgcn_mfma_f32_32x32x16_bf16(kf[d0][1], qr[d0], p1, 0, 0, 0); } while (0)
        QKH(4, 0); QKH(4, 1); PINP(); KRD1(0); PINP(); QKH(5, 0); PINP(); KRD1(1); PINP(); QKH(5, 1); PINP(); KRD1(2); PINP();
        o[0] = __builtin_amdgcn_mfma_f32_32x32x16_bf16(pa0, VFR(0, 0), o[0], 0, 0, 0); PINO(); KRD1(3); PINO();
        o[0] = __builtin_amdgcn_mfma_f32_32x32x16_bf16(pa1, VFR(0, 1), o[0], 0, 0, 0); PINO(); KRD1(4); PINO();
        o[0] = __builtin_amdgcn_mfma_f32_32x32x16_bf16(pa2, VFR(0, 2), o[0], 0, 0, 0); PINO(); KRD1(5); PINO();
        ++j; kp += KVBLK * DQK * 2; vp += KVBLK * DV * 2;
        asm volatile("" : "+s"(j), "+s"(kp), "+s"(vp));
        o[0] = __builtin_amdgcn_mfma_f32_32x32x16_bf16(pa3, VFR(0, 3), o[0], 0, 0, 0); PINO();
        o[1] = __builtin_amdgcn_mfma_f32_32x32x16_bf16(pa0, VFR(1, 0), o[1], 0, 0, 0); PINO();
        o[1] = __builtin_amdgcn_mfma_f32_32x32x16_bf16(pa1, VFR(1, 1), o[1], 0, 0, 0); PINO();
        o[1] = __builtin_amdgcn_mfma_f32_32x32x16_bf16(pa2, VFR(1, 2), o[1], 0, 0, 0);
        o[1] = __builtin_amdgcn_mfma_f32_32x32x16_bf16(pa3, VFR(1, 3), o[1], 0, 0, 0);
#undef QKH
#undef PINP
#undef PINO
#undef VRD2
#undef KRD1
        SBAR();
        __builtin_amdgcn_s_waitcnt(0xC07F);
        asm volatile("s_waitcnt vmcnt(3)" ::: "memory");
        SBAR(); __builtin_amdgcn_s_barrier(); SBAR();
    };
    int jtrig = -1;
#define TILE_OPEN(C) SBAR(); \
            { asm volatile("" : "+v"(koff[0]), "+v"(koff[1]), "+v"(voff)); const unsigned k0_ = koff[0], k1_ = koff[1], v0_ = voff;     \
              const unsigned kd_ = (unsigned)(LDS_KR + (((C) + 4) % 5) * SHM_K) + (unsigned)wid * 1024u, vd_ = (unsigned)(LDS_VR + (((C) + 2) % 5) * SHM_V) + (unsigned)wid * 1024u; \
              __builtin_amdgcn_global_load_lds((const unsigned*)(kp + k0_), (LAS unsigned*)(lds + kd_), 16, 0, 0); \
              __builtin_amdgcn_global_load_lds((const unsigned*)(kp + k1_), (LAS unsigned*)(lds + kd_ + 8192), 16, 0, 0); \
              __builtin_amdgcn_global_load_lds((const unsigned*)(vp + v0_), (LAS unsigned*)(lds + vd_), 16, 0, 0); } \
        SBAR(); { float ps; expP0(p0); ps = expP1sum(p0, p1); \
        if (__builtin_expect(__any(!(ps < ATT_OVF)), 0)) { jtrig = j; } \
        else { lacc += ps; cvtP(p0, p1, pa0, pa1, pa2, pa3); \
            SBAR(); __builtin_amdgcn_s_barrier(); SBAR(); xsegc(IC5<(C)>{});
#define TILE_CLOSE } }
    if (!slow) {
#pragma unroll 1
        for (int it = 0; it < NT / 5 && jtrig < 0; ++it) { TILE_OPEN(0) TILE_OPEN(1) TILE_OPEN(2) TILE_OPEN(3) TILE_OPEN(4) TILE_CLOSE TILE_CLOSE TILE_CLOSE TILE_CLOSE TILE_CLOSE }
        if (jtrig < 0) { TILE_OPEN(0) TILE_CLOSE }
        if (jtrig >= 0) {
            j = jtrig; ks_cur = j % 5; ks_ld = (j + 2) % 5; ks_dma = (j + 4) % 5; vs = j % 5; vs_dma = (j + 2) % 5;
            kd = (unsigned)(LDS_KR + ks_dma * SHM_K) + (unsigned)wid * 1024u; vd = (unsigned)(LDS_VR + vs_dma * SHM_V) + (unsigned)wid * 1024u;
            reref(); }
    }
#undef TILE_OPEN
#undef TILE_CLOSE
    if (j < NT) {
#pragma unroll 1
        do {
            SBAR();
            float ps;
            expP0(p0); ps = expP1sum(p0, p1);
            if (__builtin_expect(__any(!(ps < ATT_OVF)), 0)) { reref(); expP0(p0); ps = expP1sum(p0, p1); }
            lacc += ps; cvtP(p0, p1, pa0, pa1, pa2, pa3);
            f32x16 negm;
#pragma unroll
            for (int r = 0; r < 16; ++r) { float t_; asm("v_mov_b32 %0, %1" : "=v"(t_) : "v"(nm)); negm[r] = t_; }
            SBAR(); DMA_NEXT(); SBAR(); __builtin_amdgcn_s_barrier(); SBAR();
            xseg(negm);
        } while (j < NT);
    }
#undef DMA_NEXT
    asm volatile("s_waitcnt vmcnt(0)" ::: "memory");
    if (!g1) __builtin_amdgcn_s_barrier();
    __builtin_amdgcn_s_barrier();
    float l_reg; { auto rr = __builtin_amdgcn_permlane32_swap(__float_as_uint(lacc), __float_as_uint(lacc), false, false); l_reg = __uint_as_float(rr[0]) + __uint_as_float(rr[1]); }
    if (hi == 0) li_l[r32] = l_reg; asm volatile("s_waitcnt lgkmcnt(0)" ::: "memory");
    float rli[16];
#pragma unroll
    for (int r = 0; r < 16; ++r) rli[r] = __builtin_amdgcn_rcpf(li_l[crow(r, hi)]);
    LAS bf16* stg = (LAS bf16*)(lds + wid * 4096);
#pragma unroll
    for (int r = 0; r < 16; ++r) { const int orow = crow(r, hi);
#pragma unroll
        for (int d0 = 0; d0 < 2; ++d0) stg[orow * 64 + d0 * 32 + r32] = (bf16)(cvt_pk_bf16(o[d0][r] * rli[r], 0.f) & 0xffffu); }
    asm volatile("s_waitcnt lgkmcnt(0)" ::: "memory");
    bf16* Ow = Ob + (size_t)(wid * 32) * DM;
#pragma unroll
    for (int i = 0; i < 4; ++i) { const int row = i * 8 + (lane >> 3), ch = lane & 7; const v4u v = *(const LAS v4u*)(stg + row * 64 + ch * 8); *(v4u*)(Ow + (size_t)row * DM + ch * 8) = v; }
    asm volatile("s_waitcnt lgkmcnt(0)" ::: "memory"); __builtin_amdgcn_s_barrier();
#undef DMA_K
#undef DMA_V
#undef KLOAD
#undef VLOAD
#undef QKF
#undef QKSTEP
#undef VFR
#undef NEXT5
#undef NEXT3
}
}

namespace fft {
typedef short v4i16_t __attribute__((ext_vector_type(4)));
__device__ __forceinline__ s16x4 vtr(const LAS char* p) { return __builtin_bit_cast(s16x4, __builtin_amdgcn_ds_read_tr16_b64_v4i16((LAS v4i16_t*)p)); }
__device__ __forceinline__ int b_st(int k, int c) { const int kk = (k & ~0xC) | ((k & 4) << 1) | ((k & 8) >> 1); return ((kk >> 3) * 8 + (c >> 5)) * 512 + ((kk & 7) * 32 + (c & 31)) * 2; }
template <int PASS>
__device__ __forceinline__ void fft_unit(int b, int x, const bf16* __restrict__ Zb, bf16* __restrict__ U, bf16* __restrict__ Ob, const bf16* __restrict__ Amat, const float* __restrict__ TW, LAS char* lds, const int tid) {
    const int wid = tid >> 6, lane = tid & 63, r32 = lane & 31, hi = lane >> 5;
    constexpr int NT = 2, NHALF = (PASS == 1) ? 4 : 2;
    const int mrow = (PASS == 1) ? ((r32 < 16) ? (16 * wid + r32) : (128 + 16 * wid + r32 - 16)) : (32 * (wid >> 1) + r32);
    bf16x8 af[16];
#pragma unroll
    for (int ks = 0; ks < 16; ++ks) af[ks] = *reinterpret_cast<const bf16x8*>(Amat + (size_t)mrow * 256 + 16 * ks + 8 * hi);
    {
        const unsigned lrow = (unsigned)tid >> 5, c = ((unsigned)tid & 31u) * 8u;
        LAS char* ldst = lds + b_st((int)lrow, (int)c);
        const char* ub; unsigned voff;
        if (PASS == 1) { ub = (const char*)(Zb + ((size_t)b * SEQ + x) * ZLD + ZC_FR); voff = (lrow * 128u * ZLD + c) * 2u; }
        else { ub = (const char*)(U + ((size_t)b * 128 + x) * 65536); voff = (lrow * 256u + c) * 2u; }
#pragma unroll
        for (int jb = 0; jb < 2; ++jb) {
            v4u tmp[8];
#pragma unroll
            for (int j = 0; j < 8; ++j) { const int J = jb * 8 + j; const size_t uo = (PASS == 1) ? ((size_t)(J & 7) * 16 * 128 * ZLD + (size_t)(J >> 3) * 256) * 2 : (size_t)J * 8192;
                tmp[j] = *(const v4u*)(ub + uo + voff); }
#pragma unroll
            for (int j = 0; j < 8; ++j) *(LAS v4u*)(ldst + (jb * 8 + j) * 8192) = tmp[j];
        }
    }
    __syncthreads();
#pragma unroll 1
    for (int nh = 0; nh < NHALF; ++nh) {
        const int nt0 = (PASS == 1) ? 2 * nh : 4 * (wid & 1) + 2 * nh;
        f32x16 acc[NT];
#pragma unroll
        for (int d = 0; d < NT; ++d) acc[d] = f32x16{};
        const LAS char* vb = lds + att::v_rd_base(lane) + nt0 * 512;
#pragma unroll
        for (int ks = 0; ks < 16; ++ks) {
#pragma unroll
            for (int d = 0; d < NT; ++d) { const s16x4 l = vtr(vb + ks * 8192 + d * 512), h = vtr(vb + ks * 8192 + 4096 + d * 512);
                acc[d] = __builtin_amdgcn_mfma_f32_32x32x16_bf16(af[ks], (bf16x8){l[0], l[1], l[2], l[3], h[0], h[1], h[2], h[3]}, acc[d], 0, 0, 0); }
            if (ks & 1) __builtin_amdgcn_sched_barrier(0);
        }
        if (PASS == 1) {
#pragma unroll
            for (int r = 0; r < 8; ++r) { const int k1 = 16 * wid + att::crow(r, hi); const f32x2 t = *(const f32x2*)(TW + ((size_t)k1 * 128 + x) * 2);
                bf16* ur = U + ((((size_t)b * 128 + k1) * 2 + 0) * 128 + x) * 256 + nt0 * 32; bf16* ui = ur + 128 * 256;
#pragma unroll
                for (int d = 0; d < NT; ++d) { const float re = acc[d][r], im = acc[d][r + 8];
                    const unsigned pk = cvt_pk_bf16(re * t.x + im * t.y, im * t.x - re * t.y);
                    ur[d * 32 + r32] = (bf16)(pk & 0xffffu); ui[d * 32 + r32] = (bf16)(pk >> 16); } }
        } else {
#pragma unroll
            for (int r = 0; r < 16; ++r) { const int k2 = 32 * (wid >> 1) + att::crow(r, hi); bf16* orow = Ob + ((size_t)b * SEQ + x + 128 * k2) * DM + 768 + nt0 * 32;
#pragma unroll
                for (int d = 0; d < NT; ++d) orow[d * 32 + r32] = (bf16)(cvt_pk_bf16(acc[d][r], 0.f) & 0xffffu); }
        }
    }
    __syncthreads();
}
}

#define XB_TMO      128
#define XB_XCNT(j)  (256  + 64 * (j))
#define XB_XSUB(j)  (1280 + 64 * (j))
#define XB_XGEN(j)  (2304 + 64 * (j))
#define XB_TOP      3328
#define XB_TOPGEN   3392
#define XCD_BAR_WORDS 3456
#define XB_SPIN_CAP (1u << 20)
__device__ __forceinline__ unsigned xb_ld(unsigned* p)              { return __hip_atomic_load(p, __ATOMIC_RELAXED, __HIP_MEMORY_SCOPE_AGENT); }
__device__ __forceinline__ unsigned xb_add(unsigned* p, unsigned v) { return __hip_atomic_fetch_add(p, v, __ATOMIC_RELAXED, __HIP_MEMORY_SCOPE_AGENT); }
__device__ __forceinline__ unsigned xb_xcc_id() { return (unsigned)__builtin_amdgcn_s_getreg((3 << 11) | 20) & 0xFu; }
#define XB_SPIN(cond, bar) do { unsigned _sp = 0; while (cond) { __builtin_amdgcn_s_sleep(1); \
    if ((++_sp & 255u) == 0u) { if (xb_ld(&(bar)[XB_TMO])) break; if (_sp > XB_SPIN_CAP) { atomicAdd(&(bar)[XB_TMO], 1u); break; } } } } while (0)
struct XcdBarrier { unsigned* bar; unsigned x; volatile LAS unsigned* st; };
__device__ __forceinline__ XcdBarrier xcd_barrier_post(unsigned* bar, volatile LAS unsigned* st) {
    XcdBarrier b; b.bar = bar; b.x = xb_xcc_id(); b.st = st;
    if (threadIdx.x == 0) (void)xb_add(&bar[XB_XCNT(b.x)], 1u);
    return b;
}
__device__ __forceinline__ void xcd_barrier_complete(unsigned* bar, unsigned x, unsigned& nloc, unsigned& nx) {
    const unsigned G = gridDim.x * gridDim.y * gridDim.z;
    unsigned sum, cnt, mine, sp = 0u;
    for (;;) {
        sum = 0u; cnt = 0u; mine = 0u;
#pragma unroll
        for (unsigned j = 0; j < 16; ++j) { const unsigned c = xb_ld(&bar[XB_XCNT(j)]); sum += c; cnt += (c > 0u) ? 1u : 0u; mine = (j == x) ? c : mine; }
        if (sum == G) break;
        __builtin_amdgcn_s_sleep(1);
        if ((++sp & 255u) == 0u) { if (xb_ld(&bar[XB_TMO])) break; if (sp > XB_SPIN_CAP) { atomicAdd(&bar[XB_TMO], 1u); break; } }
    }
    nloc = mine > 0u ? mine : 1u; nx = cnt > 0u ? cnt : 1u;
}
__device__ __forceinline__ void xcd_barrier(const XcdBarrier& b) {
    asm volatile("s_waitcnt vmcnt(0)" ::: "memory");
    __syncthreads();
    if (threadIdx.x == 0) {
        unsigned* bar = b.bar;
        __builtin_amdgcn_s_waitcnt(0);
        unsigned nloc = b.st[0], nx = b.st[1];
        if (nloc == 0u) { xcd_barrier_complete(bar, b.x, nloc, nx); b.st[0] = nloc; b.st[1] = nx; }
        const unsigned old = xb_add(&bar[XB_XSUB(b.x)], 1u);
        const unsigned gen = old / nloc;
        if (old + 1u == (gen + 1u) * nloc) {
            __builtin_amdgcn_fence(__ATOMIC_RELEASE, "agent");
            asm volatile("s_waitcnt vmcnt(0)" ::: "memory");
            const unsigned og = xb_add(&bar[XB_TOP], 1u);
            const unsigned tg = og / nx;
            if (og + 1u == (tg + 1u) * nx) xb_add(&bar[XB_TOPGEN], 1u);
            else XB_SPIN(xb_ld(&bar[XB_TOPGEN]) == tg, bar);
            __builtin_amdgcn_fence(__ATOMIC_ACQUIRE, "agent");
            xb_add(&bar[XB_XGEN(b.x)], 1u);
            asm volatile("s_waitcnt vmcnt(0)" ::: "memory");
        } else {
            XB_SPIN(xb_ld(&bar[XB_XGEN(b.x)]) == gen, bar);
            __builtin_amdgcn_fence(__ATOMIC_ACQUIRE, "agent");
            asm volatile("s_waitcnt vmcnt(0)" ::: "memory");
        }
    }
    __syncthreads();
}

struct Args {
    const float *x, *ln_in_g, *ln_in_b, *w_in, *g_q, *g_kv, *w_uq, *w_ukv, *w_conv, *w_out, *ln1_g, *ln1_b, *w_group, *b_group, *w_router, *b_router, *w_gate, *w_up, *w_down, *ln2_g, *ln2_b;
    float* out; unsigned char* ws; int ph_lo, ph_hi, sub, pad;
};
constexpr int PH_PER_LAYER = 11, N_PHASES = 1 + DEPTH * PH_PER_LAYER;

template <class F4> __device__ __forceinline__ void tr_item(F4 f4, bf16* WT, int ldt, int k0, int n0, LAS float* scr, int lane) {
    const int krow = lane >> 3, nq = lane & 7; f32x4 t[8];
#pragma unroll
    for (int i = 0; i < 8; ++i) t[i] = f4(k0 + 8 * i + krow, n0 + 4 * nq);
#pragma unroll
    for (int i = 0; i < 8; ++i) *(LAS f32x4*)(scr + (8 * i + krow) * 36 + 4 * nq) = t[i];
    LDS_WAIT(); asm volatile("" ::: "memory");
    const int c = lane & 7;
#pragma unroll
    for (int j = 0; j < 4; ++j) { const int n = (lane >> 3) + 8 * j; const LAS float* sp = scr + (8 * c) * 36 + n;
        v4u o; o.x = cvt_pk_bf16(sp[0 * 36], sp[1 * 36]); o.y = cvt_pk_bf16(sp[2 * 36], sp[3 * 36]); o.z = cvt_pk_bf16(sp[4 * 36], sp[5 * 36]); o.w = cvt_pk_bf16(sp[6 * 36], sp[7 * 36]);
        *(v4u*)(WT + (size_t)(n0 + n) * ldt + k0 + 8 * c) = o; }
    LDS_WAIT(); asm volatile("" ::: "memory");
}
__device__ __forceinline__ void ln_finish(f32x4 (&v)[4], const float* g, const float* bta, int lane, bf16* obf, float* of32) {
    float s = 0.f;
#pragma unroll
    for (int j = 0; j < 4; ++j) s += (v[j][0] + v[j][1]) + (v[j][2] + v[j][3]);
    const float mean = wave_sum(s) * (1.f / DM); float s2 = 0.f;
#pragma unroll
    for (int j = 0; j < 4; ++j) { v[j] = v[j] - mean; s2 += (v[j][0] * v[j][0] + v[j][1] * v[j][1]) + (v[j][2] * v[j][2] + v[j][3] * v[j][3]); }
    const float rstd = 1.f / sqrtf(wave_sum(s2) * (1.f / DM) + LN_EPS);
#pragma unroll
    for (int j = 0; j < 4; ++j) { const f32x4 gg = *(const f32x4*)(g + 4 * lane + 256 * j), bb = *(const f32x4*)(bta + 4 * lane + 256 * j);
        const f32x4 r = v[j] * rstd * gg + bb;
        if (obf) { v2u w; w.x = cvt_pk_bf16(r[0], r[1]); w.y = cvt_pk_bf16(r[2], r[3]); *(v2u*)(obf + 4 * lane + 256 * j) = w; }
        else *(f32x4*)(of32 + 4 * lane + 256 * j) = r; }
}


__device__ __forceinline__ void unpack8(const v4u w, float (&f)[8]) { f[0] = bf_lo(w.x); f[1] = bf_hi(w.x); f[2] = bf_lo(w.y); f[3] = bf_hi(w.y); f[4] = bf_lo(w.z); f[5] = bf_hi(w.z); f[6] = bf_lo(w.w); f[7] = bf_hi(w.w); }
__device__ __forceinline__ void ln16(float (&v)[16], const float* g, const float* bta, int lane, bf16* obf, float* of32) {
    float s = 0.f;
#pragma unroll
    for (int i = 0; i < 16; ++i) s += v[i];
    const float mean = wave_sum(s) * (1.f / DM); float s2 = 0.f;
#pragma unroll
    for (int i = 0; i < 16; ++i) { v[i] -= mean; s2 += v[i] * v[i]; }
    const float rstd = 1.f / sqrtf(wave_sum(s2) * (1.f / DM) + LN_EPS);
#pragma unroll
    for (int j = 0; j < 2; ++j) { const int e0 = 8 * lane + 512 * j; const f32x4 g0 = *(const f32x4*)(g + e0), g1 = *(const f32x4*)(g + e0 + 4), b0 = *(const f32x4*)(bta + e0), b1 = *(const f32x4*)(bta + e0 + 4);
        f32x4 r0, r1;
#pragma unroll
        for (int i = 0; i < 4; ++i) { r0[i] = v[8 * j + i] * rstd * g0[i] + b0[i]; r1[i] = v[8 * j + 4 + i] * rstd * g1[i] + b1[i]; }
        if (obf) { v4u w; w.x = cvt_pk_bf16(r0[0], r0[1]); w.y = cvt_pk_bf16(r0[2], r0[3]); w.z = cvt_pk_bf16(r1[0], r1[1]); w.w = cvt_pk_bf16(r1[2], r1[3]); *(v4u*)(obf + e0) = w; }
        else { *(f32x4*)(of32 + e0) = r0; *(f32x4*)(of32 + e0 + 4) = r1; } }
}
#if PROBE_CHECK
__device__ __forceinline__ float bf2f(bf16 v) { return __uint_as_float((unsigned)v << 16); }
__device__ __forceinline__ void diag_max(gu32* w, float v) { atomicMax((unsigned*)w, __float_as_uint(v < 0.f ? 0.f : v)); }
__device__ __forceinline__ void block_sum2(float& a, float& b, LAS float* red, int tid) {
    a = wave_sum(a); b = wave_sum(b); __syncthreads();
    if ((tid & 63) == 0) { red[tid >> 6] = a; red[8 + (tid >> 6)] = b; } __syncthreads();
    float sa = 0.f, sb = 0.f; for (int i = 0; i < 8; ++i) { sa += red[i]; sb += red[8 + i]; } a = sa; b = sb; __syncthreads();
}
__device__ __forceinline__ void probe_rope(int s, int j, float& cs, float& sn) {
    const int jq = j & 3; const double b4 = jq == 0 ? 1.0 : (jq == 1 ? 0.5623413251903491 : (jq == 2 ? 0.31622776601683794 : 0.1778279410038923)); const int jd = j >> 2; const double d10 = jd == 0 ? 1.0 : (jd == 1 ? 0.1 : (jd == 2 ? 0.01 : 0.001));
    const float ang = (float)s * (float)(b4 * d10); const double rev = (double)ang * 0.15915494309189535; const float fr_ = (float)(rev - floor(rev)); cs = __builtin_amdgcn_cosf(fr_); sn = __builtin_amdgcn_sinf(fr_);
}
__device__ __forceinline__ void probe_qkv(const __attribute__((address_space(4))) Args* AP, int l, int t, const bf16* Zb, const bf16* Qb, const bf16* Kb, const bf16* Vb, gu32* ctl, LAS float* sh, int tid) {
    const int b = t / SEQ, s = t - b * SEQ;
    for (int i = tid; i < 672; i += 512) sh[i] = bf2f(Zb[(size_t)t * ZLD + i]);
    __syncthreads();
    float sq = 0.f, sk = 0.f; for (int i = tid; i < 384; i += 512) sq += sh[i] * sh[i]; for (int i = tid; i < 256; i += 512) sk += sh[384 + i] * sh[384 + i];
    block_sum2(sq, sk, sh + 8000, tid);
    const float rq = 1.0f / sqrtf(sq / 384.f + RMS_EPS), rk = 1.0f / sqrtf(sk / 256.f + RMS_EPS);
    const float* wuq = AP->w_uq + (size_t)l * 384 * 768; const float* wukv = AP->w_ukv + (size_t)l * 256 * 1024; const float* gq = AP->g_q + l * 384; const float* gk = AP->g_kv + l * 256;
    for (int n = tid; n < 768; n += 512) { float a = 0.f; for (int k = 0; k < 384; ++k) a += sh[k] * gq[k] * wuq[(size_t)k * 768 + n]; sh[1024 + n] = a * rq; }
    for (int n = tid; n < 1024; n += 512) { float a = 0.f; for (int k = 0; k < 256; ++k) a += sh[384 + k] * gk[k] * wukv[(size_t)k * 1024 + n]; sh[2048 + n] = a * rk; }
    __syncthreads();
    float nq = 0.f, dq = 0.f, nk = 0.f, dk = 0.f, nv = 0.f, dv = 0.f;
    for (int i = tid; i < 768; i += 512) { const int h = i / 96, d = i - 96 * h; float ref;
        ref = sh[1024 + i];
        ref *= QSCALE; const float mine = bf2f(Qb[((size_t)(b * NH + h) * SEQ + s) * DQK + d]); nq += (ref - mine) * (ref - mine); dq += ref * ref; }
    for (int i = tid; i < 768; i += 512) { const int h = i / 96, d = i - 96 * h; float ref;
        if (d < 64) ref = sh[2048 + h * 128 + d];
        else { const int j = (d - 64) & 15; float cs, sn; probe_rope(s, j, cs, sn); const float t1 = sh[640 + j], t2 = sh[656 + j];
            ref = (d < 80) ? (t1 * cs - t2 * sn) : (t1 * sn + t2 * cs); }
        const float mine = bf2f(Kb[((size_t)(b * NH + h) * SEQ + s) * DQK + d]); nk += (ref - mine) * (ref - mine); dk += ref * ref; }
    for (int i = tid; i < 512; i += 512) { const int h = i >> 6, d = i & 63; const float ref = sh[2048 + h * 128 + 64 + d], mine = bf2f(Vb[((size_t)(b * NH + h) * SEQ + s) * DV + d]); nv += (ref - mine) * (ref - mine); dv += ref * ref; }
    block_sum2(nq, dq, sh + 8000, tid); block_sum2(nk, dk, sh + 8000, tid); block_sum2(nv, dv, sh + 8000, tid);
    if (tid == 0) { diag_max(ctl + CW_DIAG, sqrtf(nq / dq)); diag_max(ctl + CW_DIAG, sqrtf(nk / dk)); diag_max(ctl + CW_DIAG, sqrtf(nv / dv)); }
    __syncthreads();
}
__device__ __forceinline__ void probe_attn(int bh, int s, const bf16* Qb, const bf16* Kb, const bf16* Vb, const bf16* Ob, gu32* ctl, LAS float* sh, int tid) {
    const int b = bh >> 3, h = bh & 7;
    if (tid < 96) sh[tid] = bf2f(Qb[((size_t)bh * SEQ + s) * DQK + tid]);
    __syncthreads();
    if (tid < 16) { float cs, sn; probe_rope(s, tid, cs, sn); const float t1 = sh[64 + tid], t2 = sh[80 + tid]; sh[64 + tid] = t1 * cs - t2 * sn; sh[80 + tid] = t1 * sn + t2 * cs; }
    __syncthreads();
    float mx = -1e30f;
    for (int j = tid; j < SEQ; j += 512) { const bf16* kr = Kb + ((size_t)bh * SEQ + j) * DQK; float sc = 0.f;
#pragma unroll 8
        for (int d = 0; d < 96; ++d) sc += sh[d] * bf2f(kr[d]);
        sh[1024 + j] = sc; mx = fmaxf(mx, sc); }
    for (int o = 1; o < 64; o <<= 1) mx = fmaxf(mx, __shfl_xor(mx, o));
    if ((tid & 63) == 0) sh[256 + (tid >> 6)] = mx; __syncthreads();
    mx = sh[256]; for (int i = 1; i < 8; ++i) mx = fmaxf(mx, sh[256 + i]);
    const int d = tid & 63, sub = tid >> 6; float ls = 0.f, a = 0.f;
    for (int j = sub; j < SEQ; j += 8) { const float pj = exp2f(sh[1024 + j] - mx); ls += pj; a += pj * bf2f(Vb[((size_t)bh * SEQ + j) * DV + d]); }
    sh[300 + tid] = a; if (d == 0) sh[900 + sub] = ls; __syncthreads();
    float nn = 0.f, dd = 0.f;
    if (tid < 64) { float av = 0.f, lv = 0.f; for (int i = 0; i < 8; ++i) { av += sh[300 + 64 * i + tid]; lv += sh[900 + i]; }
        const float ref = av / lv, mine = bf2f(Ob[((size_t)b * SEQ + s) * DM + h * DV + tid]); nn = (ref - mine) * (ref - mine); dd = ref * ref; }
    block_sum2(nn, dd, sh + 20000, tid);
    if (tid == 0) diag_max(ctl + CW_DIAG, sqrtf(nn / dd));
    __syncthreads();
}
__device__ __forceinline__ void probe_moe(const __attribute__((address_space(4))) Args* AP, int l, int t, const bf16* Hb, const v4u* TOK, const bf16* PARTS, gu32* ctl, LAS float* sh, int tid) {
    for (int i = tid; i < 1024; i += 512) sh[i] = bf2f(Hb[(size_t)t * DM + i]);
    __syncthreads();
    if (tid < 36) { float a = 0.f; if (tid < 4) { const float* w = AP->w_group + (size_t)l * DM * 4; for (int k = 0; k < DM; ++k) a += sh[k] * w[k * 4 + tid]; a += AP->b_group[l * 4 + tid]; }
        else { const float* w = AP->w_router + (size_t)l * DM * 32; for (int k = 0; k < DM; ++k) a += sh[k] * w[k * 32 + tid - 4]; a += AP->b_router[l * 32 + tid - 4]; }
        sh[1100 + tid] = a; }
    __syncthreads();
    if (tid == 0) { int gi = 0; for (int i = 1; i < 4; ++i) if (sh[1100 + i] > sh[1100 + gi]) gi = i; float gs = 0.f; for (int i = 0; i < 4; ++i) gs += expf(sh[1100 + i] - sh[1100 + gi]); const float pg = 1.f / gs;
        const LAS float* el = sh + 1104 + 8 * gi; int i1 = 0; for (int i = 1; i < 8; ++i) if (el[i] > el[i1]) i1 = i; int i2 = (i1 == 0) ? 1 : 0; for (int i = 0; i < 8; ++i) if (i != i1 && el[i] > el[i2]) i2 = i;
        const float p1 = 1.f / (1.f + expf(el[i2] - el[i1])); const v4u ti = TOK[t]; const int e1 = ti.x & 255, e2 = ti.y & 255; float w1 = __uint_as_float(ti.z), w2 = __uint_as_float(ti.w);
        const bool same = (e1 == 8 * gi + i1) && (e2 == 8 * gi + i2);
        float werr = 0.f; if (same) { werr = fmaxf(fabsf(w1 - p1 * pg) / (p1 * pg), fabsf(w2 - (1.f - p1) * pg) / ((1.f - p1) * pg)); } else atomicAdd((unsigned*)(ctl + CW_DIAG2), 1u);
        diag_max(ctl + CW_DIAG, werr); sh[1200] = (float)e1; sh[1201] = (float)e2; sh[1202] = w1; sh[1203] = w2; }
    __syncthreads();
    for (int kx = 0; kx < 2; ++kx) { const int e = (int)sh[1200 + kx]; const float w = sh[1202 + kx]; const size_t le = (size_t)l * NEXP + e;
        const float* wg = ((tid < 256) ? AP->w_gate : AP->w_up) + le * DM * DEXP; const int f = tid & 255; float a = 0.f; for (int k = 0; k < DM; ++k) a += sh[k] * wg[(size_t)k * DEXP + f];
        sh[2048 + tid] = a; __syncthreads();
        if (tid < 256) { const float g = sh[2048 + tid], u = sh[2048 + 256 + tid]; sh[3072 + tid] = g / (1.f + expf(-g)) * u * w; } __syncthreads();
        const float* wd = AP->w_down + le * DEXP * DM; float nn = 0.f, dd = 0.f;
        for (int d = tid; d < DM; d += 512) { float a2 = 0.f; for (int ff = 0; ff < DEXP; ++ff) a2 += sh[3072 + ff] * wd[(size_t)ff * DM + d]; const float mine = bf2f(PARTS[(size_t)(2 * t + kx) * DM + d]); nn += (a2 - mine) * (a2 - mine); dd += a2 * a2; }
        block_sum2(nn, dd, sh + 8000, tid);
        if (tid == 0) diag_max(ctl + CW_DIAG, sqrtf(nn / dd));
        __syncthreads(); }
}
#endif

__global__ void __launch_bounds__(NWAVES * 64, 2) fwd(Args A) {
    extern __shared__ __attribute__((aligned(16))) unsigned char lds_raw[];
    LAS unsigned char* lds = (LAS unsigned char*)lds_raw;
    volatile LAS unsigned* MISC = (volatile LAS unsigned*)(lds + MISC_OFF);
    LAS int* seg = (LAS int*)(lds + SEG_OFF);
    const int G = gridDim.x; const int vcu = (G % 8 == 0) ? ((int)blockIdx.x % 8) * (G / 8) + (int)blockIdx.x / 8 : (int)blockIdx.x;
    for (int u = threadIdx.x; u < (LDS_BYTES - LDSCTL_OFF) / 4; u += NWAVES * 64) ((LAS unsigned*)(lds + LDSCTL_OFF))[u] = 0u;
    __syncthreads();
#if MK_PER_PHASE
#define GRID_BAR() do { } while (0)
#else
    XcdBarrier bar = xcd_barrier_post((unsigned*)(A.ws + WS_CTL) + CW_BAR, MISC + 8);
#define GRID_BAR() xcd_barrier(bar)
#endif
    const int lo = A.ph_lo, hi = A.ph_hi;
#ifndef PH_MASK
#define PH_MASK 0xFFF
#endif
#define PHM(j) (((PH_MASK) >> (j)) & 1)
#undef SUBM
#define SUBM (AP->sub)
#define IN(k) (lo <= (k) && (k) < hi)
#define SEAM(k) do { if (IN(k) && IN((k) + 1)) GRID_BAR(); } while (0)
#define PH_IDS() int tid = threadIdx.x; asm volatile("" : "+v"(tid)); const int lane = tid & 63, wave = __builtin_amdgcn_readfirstlane(tid >> 6); const int gw = vcu * NWAVES + wave, NGW = G * NWAVES; \
    const __attribute__((address_space(4))) Args* AP = (const __attribute__((address_space(4))) Args*)__builtin_amdgcn_kernarg_segment_ptr(); asm volatile("" : "+s"(AP)); \
    unsigned char* ws = AP->ws; unsigned char* dout = (unsigned char*)AP->out; (void)lane; (void)gw; (void)NGW; (void)dout; \
    gu32* ctl = (gu32*)(ws + WS_CTL); (void)ctl; \
    bf16* Hb = (bf16*)(ws + WS_H); bf16* Zb = (bf16*)(ws + WS_Z); bf16* Vb = (bf16*)(ws + WS_V); bf16* Ob = (bf16*)(ws + WS_O); \
    bf16* Qb = (bf16*)(dout + DO_Q); bf16* Kb = (bf16*)(dout + DO_K); bf16* Ub = (bf16*)(dout + DO_U); \
    bf16* Y1 = (bf16*)dout; bf16* PARTS = (bf16*)dout; bf16* XG = (bf16*)(ws + WS_Z); bf16* HID = (bf16*)(ws + WS_O); \
    float* SSQ = (float*)(ws + WS_SSQ); float* LG = (float*)(ws + WS_LG); v4u* TOK = (v4u*)(ws + WS_TOK); \
    int* ROWTOK = (int*)(ws + WS_ROWTOK); float* ROWW = (float*)(ws + WS_ROWTOK + 512 * 1024); \
    float* RCOS = (float*)(ws + WS_ROPE); float* RSIN = RCOS + SEQ * 16; \
    bf16* FA1 = (bf16*)(ws + WS_FA1); bf16* FA2 = FA1 + 256 * 256; float* TW = (float*)(ws + WS_FA1 + 256 * 1024); \
    (void)Hb; (void)Zb; (void)Vb; (void)Ob; (void)Qb; (void)Kb; (void)Ub; (void)Y1; (void)PARTS; (void)XG; (void)HID; (void)SSQ; (void)LG; (void)TOK; (void)ROWTOK; (void)ROWW; (void)RCOS; (void)RSIN; (void)FA1; (void)FA2; (void)TW;

    if (PHM(0) && IN(0)) { PH_IDS()
        LAS float* scr = (LAS float*)(lds + wave * 16384);
        int it = gw;
#define JOB_BEGIN(cnt) { const int cnt_ = (cnt); for (; it < cnt_; it += NGW) {
#define JOB_END } it -= cnt_; }
        JOB_BEGIN(DEPTH * 16 * 45) const int l = it / (16 * 45), r = it % (16 * 45), kb = r / 45, nb = r % 45; const int n0 = nb < 21 ? 32 * nb : 768 + 32 * (nb - 21), sc = nb < 21 ? 0 : -96;
            const float* W = AP->w_in + (size_t)l * DM * DIN; tr_item([&](int k, int n) { return *(const f32x4*)(W + (size_t)k * DIN + n + sc); }, (bf16*)(ws + WS_WIN) + (size_t)l * ZLD * DM, DM, 64 * kb, n0, scr, lane);  JOB_END
        JOB_BEGIN(DEPTH * 6 * 24) const int l = it / (6 * 24), r = it % (6 * 24), kb = r / 24, nb = r % 24; const float* W = AP->w_uq + (size_t)l * QLORA * 768; const float* gq = AP->g_q + l * QLORA;
            tr_item([&](int k, int n) { return *(const f32x4*)(W + (size_t)k * 768 + n) * gq[k]; }, (bf16*)(ws + WS_WUQ + l * MiB), QLORA, 64 * kb, 32 * nb, scr, lane);  JOB_END
        JOB_BEGIN(DEPTH * 4 * 32) const int l = it / (4 * 32), r = it % (4 * 32), kb = r / 32, nb = r % 32; const float* W = AP->w_ukv + (size_t)l * KVLORA * 1024; const float* gk = AP->g_kv + l * KVLORA;
            const int n0 = 32 * nb; const int src0 = n0 < 512 ? (n0 >> 6) * 128 + (n0 & 63) : ((n0 - 512) >> 6) * 128 + 64 + ((n0 - 512) & 63);
            tr_item([&](int k, int n) { return *(const f32x4*)(W + (size_t)k * 1024 + src0 + (n - n0)) * gk[k]; }, (bf16*)(ws + WS_WUKV + l * MiB), KVLORA, 64 * kb, n0, scr, lane);  JOB_END
        JOB_BEGIN(DEPTH * 16 * 32) const int l = it / (16 * 32), r = it % (16 * 32), kb = r / 32, nb = r % 32; const float* W = AP->w_out + (size_t)l * DM * DM;
            tr_item([&](int k, int n) { return *(const f32x4*)(W + (size_t)k * DM + n); }, (bf16*)(ws + WS_WOUT) + (size_t)l * DM * DM, DM, 64 * kb, 32 * nb, scr, lane);  JOB_END
        JOB_BEGIN(NEXP * 16 * 16) const int le = it / 256, r = it % 256, kb = r / 16, nb = r % 16; const int n0 = 32 * nb, pn = n0 >> 8, j0 = n0 & 255;
            const float* W = ((j0 < 128) ? AP->w_gate : AP->w_up) + (size_t)le * DM * DEXP; const int src0 = 128 * pn + (j0 & 127);
            tr_item([&](int k, int n) { return *(const f32x4*)(W + (size_t)k * DEXP + src0 + (n - n0)); }, (bf16*)(ws + WS_WGU) + (size_t)le * 512 * DM, DM, 64 * kb, n0, scr, lane);  JOB_END
        JOB_BEGIN(NEXP * 4 * 32) const int le = it / 128, r = it % 128, kb = r / 32, nb = r % 32; const float* W = AP->w_down + (size_t)le * DEXP * DM;
            tr_item([&](int k, int n) { return *(const f32x4*)(W + (size_t)k * DM + n); }, (bf16*)(ws + WS_WD) + (size_t)le * DM * DEXP, DEXP, 64 * kb, 32 * nb, scr, lane);  JOB_END
        JOB_BEGIN(DEPTH * 4 * 16 * 8) const int l = it / 512, r = it % 512, g4 = r / 128, kb = (r / 8) % 16, cb = r % 8; const int k = 64 * kb + lane;
            const float* wr = AP->w_in + (size_t)l * DM * DIN + (size_t)k * DIN + 1440 + 64 * g4; float fv[64];
#pragma unroll
            for (int c = 0; c < 64; c += 4) { const f32x4 t4 = *(const f32x4*)(wr + c); fv[c] = t4[0]; fv[c + 1] = t4[1]; fv[c + 2] = t4[2]; fv[c + 3] = t4[3]; }
            bf16* dst = (bf16*)(ws + WS_WIN) + (size_t)l * ZLD * DM;
            for (int cc = 0; cc < 8; ++cc) { const int cp = 8 * cb + cc; float ar = 0.f, ai = 0.f;
#pragma unroll
                for (int c = 0; c < 64; ++c) { const float fr_ = (float)((c * cp) & 63) * (1.0f / 64.0f); ar += fv[c] * __builtin_amdgcn_cosf(fr_); ai -= fv[c] * __builtin_amdgcn_sinf(fr_); }
                dst[(size_t)(ZC_FR + 64 * g4 + cp) * DM + k] = (bf16)(cvt_pk_bf16(ar * 0.125f, 0.f) & 0xffffu);
                dst[(size_t)(ZC_FR + 256 + 64 * g4 + cp) * DM + k] = (bf16)(cvt_pk_bf16(ai * 0.125f, 0.f) & 0xffffu); }  JOB_END
        JOB_BEGIN(DEPTH * 96 * 128) const int l = it / (96 * 128), r = it % (96 * 128), n = 672 + r / 128, kc = r % 128; *(v4u*)((bf16*)(ws + WS_WIN) + (size_t)l * ZLD * DM + (size_t)n * DM + 8 * kc) = (v4u){0u, 0u, 0u, 0u};  JOB_END
        JOB_BEGIN(DEPTH * 256 * 128) const int l = it / (256 * 128), r = it % (256 * 128), n = r / 128, kc = r % 128; float v[8];
#pragma unroll
            for (int i = 0; i < 8; ++i) { const int k = 8 * kc + i; v[i] = n < 4 ? AP->w_group[(size_t)l * DM * 4 + (size_t)k * 4 + n] : (n < 36 ? AP->w_router[(size_t)l * DM * 32 + (size_t)k * 32 + (n - 4)] : 0.f); }
            v4u o; o.x = cvt_pk_bf16(v[0], v[1]); o.y = cvt_pk_bf16(v[2], v[3]); o.z = cvt_pk_bf16(v[4], v[5]); o.w = cvt_pk_bf16(v[6], v[7]);
            *(v4u*)((bf16*)(ws + WS_WR) + (size_t)l * 256 * DM + (size_t)n * DM + 8 * kc) = o;  JOB_END
#undef JOB_BEGIN
#undef JOB_END
        const int gt = vcu * (NWAVES * 64) + tid, NGT = G * NWAVES * 64;
        for (int i = gt; i < SEQ * 16; i += NGT) { const int s = i >> 4, j = i & 15; const int jq = j & 3; const double b4 = jq == 0 ? 1.0 : (jq == 1 ? 0.5623413251903491 : (jq == 2 ? 0.31622776601683794 : 0.1778279410038923)); const int jd = j >> 2; const double d10 = jd == 0 ? 1.0 : (jd == 1 ? 0.1 : (jd == 2 ? 0.01 : 0.001)); const float invf = (float)(b4 * d10); const float ang = (float)s * invf;
            const double rev = (double)ang * 0.15915494309189535; const float fr_ = (float)(rev - floor(rev)); RCOS[i] = __builtin_amdgcn_cosf(fr_); RSIN[i] = __builtin_amdgcn_sinf(fr_); }
        for (int i = gt; i < 256 * 256; i += NGT) { const int m = i >> 8, k = i & 255, ro = m >> 7, k1 = m & 127, ri = k >> 7, s1 = k & 127; const float fr_ = (float)((k1 * s1) & 127) * (1.0f / 128.0f);
            const float c = __builtin_amdgcn_cosf(fr_) * 0.08838834764831845f, s = __builtin_amdgcn_sinf(fr_) * 0.08838834764831845f;
            const float v = (ro == ri) ? c : (ro == 0 ? s : -s); FA1[i] = (bf16)(cvt_pk_bf16(v, 0.f) & 0xffffu); }
        for (int i = gt; i < 128 * 256; i += NGT) { const int k2 = i >> 8, k = i & 255, ri = k >> 7, s2 = k & 127; const float fr_ = (float)((k2 * s2) & 127) * (1.0f / 128.0f);
            const float v = (ri == 0 ? __builtin_amdgcn_cosf(fr_) : __builtin_amdgcn_sinf(fr_)) * 0.08838834764831845f; FA2[i] = (bf16)(cvt_pk_bf16(v, 0.f) & 0xffffu); }
        for (int i = gt; i < 128 * 128; i += NGT) { const int k1 = i >> 7, s2 = i & 127; const float fr_ = (float)(k1 * s2) * (1.0f / 16384.0f); TW[2 * i] = __builtin_amdgcn_cosf(fr_); TW[2 * i + 1] = __builtin_amdgcn_sinf(fr_); }
        for (int m0 = 2 * gw; m0 < NTOK; m0 += 2 * NGW) { float va[16], vb[16];
#pragma unroll
            for (int j = 0; j < 2; ++j) { const float* xa = AP->x + (size_t)m0 * DM + 8 * lane + 512 * j; const f32x4 a0 = __builtin_nontemporal_load((const f32x4*)xa), a1 = __builtin_nontemporal_load((const f32x4*)(xa + 4)), b0 = __builtin_nontemporal_load((const f32x4*)(xa + DM)), b1 = __builtin_nontemporal_load((const f32x4*)(xa + DM + 4));
#pragma unroll
                for (int i = 0; i < 4; ++i) { va[8 * j + i] = a0[i]; va[8 * j + 4 + i] = a1[i]; vb[8 * j + i] = b0[i]; vb[8 * j + 4 + i] = b1[i]; } }
            ln16(va, AP->ln_in_g, AP->ln_in_b, lane, Hb + (size_t)m0 * DM, nullptr); ln16(vb, AP->ln_in_g, AP->ln_in_b, lane, Hb + (size_t)(m0 + 1) * DM, nullptr); }
    }
    SEAM(0);

#pragma unroll 1
    for (int l = 0; l < DEPTH; ++l) {
        const int pb = 1 + l * PH_PER_LAYER;
        if (PHM(1) && IN(pb + 0)) { PH_IDS()
            pg8::Gemm g{Hb, (const bf16*)(ws + WS_WIN) + (size_t)l * ZLD * DM, DM, DM, DM, 0}; pg8::LinOrder S{ZLD / 256, (NTOK / 256) * (ZLD / 256), G, vcu};
            EpiZ E{Zb, SSQ}; pg8::gemm_phase<EpiZ, pg8::LinOrder>(lds, g, S, E, tid);
        }
        SEAM(pb + 0);
        if (PHM(2) && IN(pb + 1)) { PH_IDS()
            if (SUBM & 1) { pg8::Gemm g{Zb, (const bf16*)(ws + WS_WUQ + l * MiB), ZLD, QLORA, QLORA, 0}; pg8::LinOrder S{3, (NTOK / 256) * 3, G, vcu};
              EpiQ E{Qb, SSQ}; pg8::gemm_phase<EpiQ, pg8::LinOrder>(lds, g, S, E, tid); }
            asm volatile("" : "+v"(tid));
            if (SUBM & 2) { pg8::Gemm g{Zb + QLORA, (const bf16*)(ws + WS_WUKV + l * MiB), ZLD, KVLORA, KVLORA, 0}; pg8::KvOrder S{G, vcu};
              EpiKV E{Kb, Vb, Zb, SSQ, RCOS, RSIN, tid}; pg8::gemm_phase<EpiKV, pg8::KvOrder>(lds, g, S, E, tid); }
            asm volatile("" : "+v"(tid));
            if (SUBM & 4) { const float* wc = AP->w_conv + (size_t)l * 3 * 256; const int gt = vcu * (NWAVES * 64) + tid, NGT = G * NWAVES * 64;
              float cw[3][8]; { const int c0w = (gt & 31) * 8;
#pragma unroll
                  for (int k3 = 0; k3 < 3; ++k3)
#pragma unroll
                      for (int q8 = 0; q8 < 8; ++q8) cw[k3][q8] = wc[256 * k3 + c0w + q8]; }
              for (int i = gt; i < NTOK * 32; i += NGT) { const int t = i >> 5, c0 = (i & 31) * 8, s = t & (SEQ - 1); const bf16* zr = Zb + (size_t)t * ZLD;
                  const v4u bb = *(const v4u*)(zr + ZC_B + c0), c1 = *(const v4u*)(zr + ZC_C + c0), h1 = *(const v4u*)(zr + ZC_H + c0);
                  v4u cm = {0u, 0u, 0u, 0u}, hm = cm, cp = cm, hp = cm;
                  if (s > 0) { cm = *(const v4u*)(zr - ZLD + ZC_C + c0); hm = *(const v4u*)(zr - ZLD + ZC_H + c0); }
                  if (s < SEQ - 1) { cp = *(const v4u*)(zr + ZLD + ZC_C + c0); hp = *(const v4u*)(zr + ZLD + ZC_H + c0); }
                  float o[8];
#pragma unroll
                  for (int q = 0; q < 4; ++q) {
                      const float w0a = cw[0][2 * q], w1a = cw[1][2 * q], w2a = cw[2][2 * q], w0b = cw[0][2 * q + 1], w1b = cw[1][2 * q + 1], w2b = cw[2][2 * q + 1];
                      o[2 * q] = bf_lo(bb[q]) * (w0a * bf_lo(cm[q]) * bf_lo(hm[q]) + w1a * bf_lo(c1[q]) * bf_lo(h1[q]) + w2a * bf_lo(cp[q]) * bf_lo(hp[q]));
                      o[2 * q + 1] = bf_hi(bb[q]) * (w0b * bf_hi(cm[q]) * bf_hi(hm[q]) + w1b * bf_hi(c1[q]) * bf_hi(h1[q]) + w2b * bf_hi(cp[q]) * bf_hi(hp[q])); }
                  v4u w; w.x = cvt_pk_bf16(o[0], o[1]); w.y = cvt_pk_bf16(o[2], o[3]); w.z = cvt_pk_bf16(o[4], o[5]); w.w = cvt_pk_bf16(o[6], o[7]);
                  *(v4u*)(Ob + (size_t)t * DM + 512 + c0) = w; } }
            __syncthreads();
            asm volatile("" : "+v"(tid));
            if (SUBM & 8) for (int u = vcu; u < BATCH * 128; u += G) fft::fft_unit<1>(u >> 7, u & 127, Zb, Ub, Ob, FA1, TW, (LAS char*)lds, tid);
        }
        SEAM(pb + 1);
        if (PHM(3) && IN(pb + 2)) { PH_IDS()
            if (SUBM & 1) for (int u = vcu; u < BATCH * 128; u += G) fft::fft_unit<2>(u >> 7, u & 127, Zb, Ub, Ob, FA2, TW, (LAS char*)lds, tid);
            asm volatile("" : "+v"(tid));
            if (SUBM & 2) for (int L = vcu; L < BATCH * NH * (SEQ / 256); L += G) { const int bh = L >> 6, qb = L & 63, b = bh >> 3, h = bh & 7;
                att::attn_unit(Qb + ((size_t)bh * SEQ + qb * 256) * DQK, Kb + (size_t)bh * SEQ * DQK, Vb + (size_t)bh * SEQ * DV, Ob + ((size_t)b * SEQ + qb * 256) * DM + h * DV, (LAS char*)lds, tid, RCOS, RSIN, qb * 256); }
        }
        SEAM(pb + 2);
#if PROBE_CHECK == 1 || PROBE_CHECK == 2
        { PH_IDS()
          if (PROBE_CHECK == 1) probe_qkv(AP, l, (vcu * 977 + 131 * l) & (NTOK - 1), Zb, Qb, Kb, Vb, ctl, (LAS float*)lds, tid);
          else probe_attn(vcu & 15, (vcu * 1021 + 77 + 4000 * l) & (SEQ - 1), Qb, Kb, Vb, Ob, ctl, (LAS float*)lds, tid);
          GRID_BAR(); }
#endif
        if (PHM(4) && IN(pb + 3)) { PH_IDS()
            pg8::Gemm g{Ob, (const bf16*)(ws + WS_WOUT) + (size_t)l * DM * DM, DM, DM, DM, 0}; pg8::LinOrder S{4, (NTOK / 256) * 4, G, vcu};
            EpiOut E{Y1}; pg8::gemm_phase<EpiOut, pg8::LinOrder>(lds, g, S, E, tid);
        }
        SEAM(pb + 3);
        if (PHM(5) && IN(pb + 4)) { PH_IDS()
            bf16* hout = (SUBM & 16) ? Ob : Hb;
            for (int m0 = 2 * gw; m0 < NTOK; m0 += 2 * NGW) { float va[16], vb[16];
#pragma unroll
                for (int j = 0; j < 2; ++j) { const size_t eo = (size_t)m0 * DM + 8 * lane + 512 * j;
                    const v4u ha = __builtin_nontemporal_load((const v4u*)(Hb + eo)), ya = __builtin_nontemporal_load((const v4u*)(Y1 + eo)), hb = __builtin_nontemporal_load((const v4u*)(Hb + eo + DM)), yb = __builtin_nontemporal_load((const v4u*)(Y1 + eo + DM));
                    float fh[8], fy[8]; unpack8(ha, fh); unpack8(ya, fy);
#pragma unroll
                    for (int i = 0; i < 8; ++i) va[8 * j + i] = fy[i] + ALPHA * fh[i];
                    unpack8(hb, fh); unpack8(yb, fy);
#pragma unroll
                    for (int i = 0; i < 8; ++i) vb[8 * j + i] = fy[i] + ALPHA * fh[i]; }
                ln16(va, AP->ln1_g + l * DM, AP->ln1_b + l * DM, lane, hout + (size_t)m0 * DM, nullptr); ln16(vb, AP->ln1_g + l * DM, AP->ln1_b + l * DM, lane, hout + (size_t)(m0 + 1) * DM, nullptr); }
        }
        SEAM(pb + 4);
        if (PHM(6) && IN(pb + 5)) { PH_IDS()
            pg8::Gemm g{Hb, (const bf16*)(ws + WS_WR) + (size_t)l * 256 * DM, DM, DM, DM, 0}; pg8::LinOrder S{1, NTOK / 256, G, vcu};
            EpiLogits E{LG}; pg8::gemm_phase<EpiLogits, pg8::LinOrder>(lds, g, S, E, tid);
        }
        if (IN(pb + 5) && IN(pb + 6)) { asm volatile("s_waitcnt vmcnt(0)" ::: "memory"); __syncthreads(); }
        if (PHM(7) && IN(pb + 6)) { PH_IDS()
            LAS int* lcnt = (LAS int*)(lds + RT_OFF); int* CNTS = (int*)(ws + WS_CNTS);
            for (int ch0 = 2 * vcu; ch0 < NTOK / 128; ch0 += 2 * G) {
                if (tid < 64) lcnt[tid] = 0;
                __syncthreads();
                int e1 = 0, e2 = 0, r1 = 0, r2 = 0; float w1 = 0.f, w2 = 0.f; const int csel = (tid >> 7) & 1; const int ch = ch0 + csel; const int t = ch * 128 + (tid & 127);
                if (tid < 256) {
                    const float* lg = LG + (size_t)t * 64; float gl[4]; int gi = 0;
#pragma unroll
                    for (int i = 0; i < 4; ++i) gl[i] = lg[i] + AP->b_group[l * 4 + i];
                    float gmax = gl[0];
#pragma unroll
                    for (int i = 1; i < 4; ++i) if (gl[i] > gmax) { gmax = gl[i]; gi = i; }
                    float gs = 0.f;
#pragma unroll
                    for (int i = 0; i < 4; ++i) gs += __expf(gl[i] - gmax);
                    const float pg = 1.0f / gs;
                    float el[8];
#pragma unroll
                    for (int i = 0; i < 8; ++i) el[i] = lg[4 + 8 * gi + i] + AP->b_router[l * 32 + 8 * gi + i];
                    int i1 = 0; float m1 = el[0];
#pragma unroll
                    for (int i = 1; i < 8; ++i) if (el[i] > m1) { m1 = el[i]; i1 = i; }
                    int i2 = 0; float m2 = -3.0e38f;
#pragma unroll
                    for (int i = 0; i < 8; ++i) if (i != i1 && el[i] > m2) { m2 = el[i]; i2 = i; }
                    const float x2 = __expf(m2 - m1); const float p1 = 1.0f / (1.0f + x2);
                    w1 = p1 * pg; w2 = (1.0f - p1) * pg; e1 = 8 * gi + i1; e2 = 8 * gi + i2;
                    r1 = atomicAdd((int*)&lcnt[32 * csel + e1], 1); r2 = atomicAdd((int*)&lcnt[32 * csel + e2], 1);
                }
                __syncthreads();
                if (tid < 64) CNTS[((size_t)l * 256 + ch0 + (tid >> 5)) * 32 + (tid & 31)] = lcnt[tid];
                if (tid < 256) { v4u o; o.x = (unsigned)e1 | ((unsigned)r1 << 8); o.y = (unsigned)e2 | ((unsigned)r2 << 8); o.z = __float_as_uint(w1); o.w = __float_as_uint(w2); TOK[t] = o; }
                __syncthreads();
            }
        }
        SEAM(pb + 6);
        LAS int* pre = (LAS int*)lds; LAS int* segc = seg + 40;
        if (IN(pb + 7)) { PH_IDS()
            const int* CN = (const int*)(ws + WS_CNTS) + (size_t)l * 256 * 32;
            for (int i = tid; i < 256 * 32 / 4; i += NWAVES * 64) *(LAS v4u*)(pre + 4 * i) = *(const v4u*)(CN + 4 * i);
            __syncthreads();
            {
                const int e = tid & 31, part = tid >> 5; LAS int* psum = pre + 256 * 32; int cv[16]; int sloc = 0;
#pragma unroll
                for (int j = 0; j < 16; ++j) { cv[j] = pre[(16 * part + j) * 32 + e]; sloc += cv[j]; }
                psum[part * 32 + e] = sloc;
                __syncthreads();
                int acc = 0;
#pragma unroll
                for (int p2 = 0; p2 < 15; ++p2) acc += (p2 < part) ? psum[p2 * 32 + e] : 0;
#pragma unroll
                for (int j = 0; j < 16; ++j) { pre[(16 * part + j) * 32 + e] = acc; acc += cv[j]; }
                if (part == 15) segc[e] = acc;
            }
            __syncthreads();
            if (tid == 0) { int acc = 0; for (int e = 0; e < NEXP; ++e) { seg[e] = acc; acc += (segc[e] + 255) >> 8; } seg[32] = acc; }
            __syncthreads();
        } else if (IN(pb + 8) || IN(pb + 9)) { PH_IDS()
            const int* CN = (const int*)(ws + WS_CNTS) + (size_t)l * 256 * 32;
            if (tid < 32) { int acc = 0; for (int ch = 0; ch < 256; ++ch) acc += CN[ch * 32 + tid]; segc[tid] = acc; }
            __syncthreads();
            if (tid == 0) { int acc = 0; for (int e = 0; e < NEXP; ++e) { seg[e] = acc; acc += (segc[e] + 255) >> 8; } seg[32] = acc; }
            __syncthreads();
        }
        if (PHM(8) && IN(pb + 7)) { PH_IDS()
            for (int t0 = 2 * gw; t0 < NTOK; t0 += 2 * NGW) { const v4u ti = TOK[t0], tj = TOK[t0 + 1];
                const int a1 = seg[ti.x & 255] * 256 + pre[(t0 >> 7) * 32 + (ti.x & 255)] + (int)(ti.x >> 8), a2 = seg[ti.y & 255] * 256 + pre[(t0 >> 7) * 32 + (ti.y & 255)] + (int)(ti.y >> 8);
                const int b1 = seg[tj.x & 255] * 256 + pre[(t0 >> 7) * 32 + (tj.x & 255)] + (int)(tj.x >> 8), b2 = seg[tj.y & 255] * 256 + pre[(t0 >> 7) * 32 + (tj.y & 255)] + (int)(tj.y >> 8);
                if (lane == 0) { ROWTOK[a1] = 2 * t0; ROWW[a1] = __uint_as_float(ti.z); ROWTOK[a2] = 2 * t0 + 1; ROWW[a2] = __uint_as_float(ti.w);
                                 ROWTOK[b1] = 2 * t0 + 2; ROWW[b1] = __uint_as_float(tj.z); ROWTOK[b2] = 2 * t0 + 3; ROWW[b2] = __uint_as_float(tj.w); } }
            for (int e = vcu; e < NEXP; e += G) { const int c = segc[e];
                for (int r = seg[e] * 256 + c + tid; r < seg[e + 1] * 256; r += NWAVES * 64) { ROWTOK[r] = -1; ROWW[r] = 0.f; } }
        }
        SEAM(pb + 7);
        if (PHM(9) && IN(pb + 8)) { PH_IDS()
            LAS int* gidx = (LAS int*)(lds + GIDX_OFF); const int total9 = seg[32] * 2;
            for (int i = 0; i < 3; ++i) { const int L = i * G + vcu; if (L < total9 && tid < 256) { const int v = ROWTOK[(L >> 1) * 256 + tid]; gidx[i * 256 + tid] = v < 0 ? 0 : (v >> 1); } }
            __syncthreads();
            pg8::Gemm g{Hb, (const bf16*)(ws + WS_WGU) + (size_t)l * NEXP * 512 * DM, DM, DM, DM, (size_t)512 * DM * 2}; pg8::MoeGatherOrder S{{2, total9, G, vcu, seg}, gidx};
            EpiGU E{HID, ROWW}; pg8::gemm_phase<EpiGU, pg8::MoeGatherOrder>(lds, g, S, E, tid);
            if (l + 1 < DEPTH) { const int total = seg[32] * 2, busy = total % G;
                if (vcu >= busy) { LAS float* scr = (LAS float*)(lds + wave * 16384); const int np = G - busy, gwp = (vcu - busy) * NWAVES + wave, ngwp = np * NWAVES; const int l1 = l + 1;
                    __syncthreads();
                    for (int it = gwp; it < NEXP * 256; it += ngwp) { const int le = l1 * NEXP + it / 256, r = it % 256, kb = r / 16, nb = r % 16; const int n0 = 32 * nb, pn = n0 >> 8, j0 = n0 & 255;
                        const float* W = ((j0 < 128) ? AP->w_gate : AP->w_up) + (size_t)le * DM * DEXP; const int src0 = 128 * pn + (j0 & 127);
                        tr_item([&](int k, int n) { return *(const f32x4*)(W + (size_t)k * DEXP + src0 + (n - n0)); }, (bf16*)(ws + WS_WGU) + (size_t)le * 512 * DM, DM, 64 * kb, n0, scr, lane); }
                    for (int it = gwp; it < NEXP * 128; it += ngwp) { const int le = l1 * NEXP + it / 128, r = it % 128, kb = r / 32, nb = r % 32; const float* W = AP->w_down + (size_t)le * DEXP * DM;
                        tr_item([&](int k, int n) { return *(const f32x4*)(W + (size_t)k * DM + n); }, (bf16*)(ws + WS_WD) + (size_t)le * DM * DEXP, DEXP, 64 * kb, 32 * nb, scr, lane); } } }
        }
        SEAM(pb + 8);
        if (PHM(10) && IN(pb + 9)) { PH_IDS()
            pg8::Gemm g{HID, (const bf16*)(ws + WS_WD) + (size_t)l * NEXP * DM * DEXP, DEXP, DEXP, DEXP, (size_t)DM * DEXP * 2}; pg8::MoeOrder S{4, seg[32] * 4, G, vcu, seg};
            EpiDown E{PARTS, ROWTOK}; pg8::gemm_phase<EpiDown, pg8::MoeOrder>(lds, g, S, E, tid);
        }
        SEAM(pb + 9);
#if PROBE_CHECK == 3 || PROBE_CHECK == 4
        { PH_IDS()
          probe_moe(AP, l, (vcu * 977 + 131 * l + 5) & (NTOK - 1), Hb, TOK, PARTS, ctl, (LAS float*)lds, tid);
          GRID_BAR(); }
#endif
        if (PHM(11) && IN(pb + 10)) { PH_IDS()
            const bool lastl = (l == DEPTH - 1); const bool dry = (SUBM & 16) != 0;
            for (int m0 = 4 * gw; m0 < NTOK; m0 += 4 * NGW) { v4u hx[4][2], q0[4][2], q1[4][2];
#pragma unroll
                for (int r = 0; r < 4; ++r)
#pragma unroll
                    for (int j = 0; j < 2; ++j) { const size_t eo = (size_t)(m0 + r) * DM + 8 * lane + 512 * j, po = (size_t)(2 * (m0 + r)) * DM + 8 * lane + 512 * j;
                        hx[r][j] = __builtin_nontemporal_load((const v4u*)(Hb + eo)); q0[r][j] = __builtin_nontemporal_load((const v4u*)(PARTS + po)); q1[r][j] = __builtin_nontemporal_load((const v4u*)(PARTS + po + DM)); }
                asm volatile("s_waitcnt vmcnt(0)" ::: "memory");
#pragma unroll
                for (int r = 0; r < 4; ++r) { float va[16];
#pragma unroll
                    for (int j = 0; j < 2; ++j) { float fh[8], f0[8], f1[8]; unpack8(hx[r][j], fh); unpack8(q0[r][j], f0); unpack8(q1[r][j], f1);
#pragma unroll
                        for (int i = 0; i < 8; ++i) va[8 * j + i] = ALPHA * fh[i] + (f0[i] + f1[i]); }
                    if (lastl) ln16(va, AP->ln2_g + l * DM, AP->ln2_b + l * DM, lane, nullptr, (dry ? (float*)Zb : AP->out) + (size_t)(m0 + r) * DM);
                    else ln16(va, AP->ln2_g + l * DM, AP->ln2_b + l * DM, lane, (dry ? Zb : Hb) + (size_t)(m0 + r) * DM, nullptr); } }
        }
        if (l + 1 < DEPTH) SEAM(pb + 10);
    }
#if PROBE_CHECK
    { GRID_BAR(); PH_IDS()
      float dg = __uint_as_float(__hip_atomic_load((unsigned*)(ctl + CW_DIAG), RLX_AGENT));
      if (PROBE_CHECK == 4) dg = (float)__hip_atomic_load((unsigned*)(ctl + CW_DIAG2), RLX_AGENT) * (1.0f / 512.0f);
      const float sc = 1.0f + 10.0f * dg;
      for (int m = gw; m < NTOK; m += NGW) { f32x4* o = (f32x4*)(AP->out + (size_t)m * DM) + lane;
#pragma unroll
          for (int j = 0; j < 4; ++j) o[64 * j] = o[64 * j] * sc; } }
#endif
#undef IN
#undef SEAM
}

extern "C" void kernel_launch(void* const* d_in, const int* in_sizes, int n_in, void* d_out, int out_size, void* d_ws, size_t ws_size, hipStream_t stream) {
    static int grid = 0;
    if (grid == 0) {
        if (n_in != 21 || in_sizes[0] != NTOK * DM || out_size != NTOK * DM || ws_size < WS_END) { fprintf(stderr, "kernel_launch: shape/workspace mismatch (n_in %d, in0 %d, out %d, ws %zu, need %zu)\n", n_in, n_in > 0 ? in_sizes[0] : -1, out_size, ws_size, (size_t)WS_END); grid = -1; return; }
        int dev = 0, cus = 0, per_cu = 0;
        if (hipGetDevice(&dev) != hipSuccess || hipDeviceGetAttribute(&cus, hipDeviceAttributeMultiprocessorCount, dev) != hipSuccess) { grid = -1; return; }
        if (hipFuncSetAttribute((const void*)fwd, hipFuncAttributeMaxDynamicSharedMemorySize, LDS_BYTES) != hipSuccess) { fprintf(stderr, "kernel_launch: hipFuncSetAttribute failed\n"); grid = -1; return; }
        if (hipOccupancyMaxActiveBlocksPerMultiprocessor(&per_cu, (const void*)fwd, NWAVES * 64, LDS_BYTES) != hipSuccess || per_cu < 1) { fprintf(stderr, "kernel_launch: occupancy query says %d\n", per_cu); }
        (void)hipGetLastError();
        grid = cus;
    }
    if (grid < 0) return;
    if (hipMemsetAsync((char*)d_ws + WS_CTL, 0, CTL_ZERO_BYTES, stream) != hipSuccess) return;
    Args a{};
    const float** ap = (const float**)&a;
    for (int i = 0; i < 21; ++i) ap[i] = (const float*)d_in[i];
    a.out = (float*)d_out; a.ws = (unsigned char*)d_ws; a.sub = 0xF;
#if MK_PER_PHASE
#ifndef REP_SUB
#define REP_SUB 0xF
#endif
#ifndef REP_MASK
#define REP_MASK 0
#endif
    for (int p = 0; p < N_PHASES; ++p) { a.ph_lo = p; a.ph_hi = p + 1; const int j = p == 0 ? 0 : (p - 1) % PH_PER_LAYER + 1;
        for (int rep = 0; rep < (((REP_MASK >> j) & 1) ? 2 : 1); ++rep) { a.sub = rep ? REP_SUB : 0xF; hipLaunchKernelGGL(fwd, dim3(grid), dim3(NWAVES * 64), LDS_BYTES, stream, a); } a.sub = 0xF; }
#else
    a.ph_lo = 0; a.ph_hi = N_PHASES; hipLaunchKernelGGL(fwd, dim3(grid), dim3(NWAVES * 64), LDS_BYTES, stream, a);
#endif
    const hipError_t le = hipPeekAtLastError();
    if (le != hipSuccess) fprintf(stderr, "kernel_launch: launch failed: %s\n", hipGetErrorName(le));
}
```
